# Optimizing an MI355X kernel written in HIP

```python
import math
import jax
import jax.numpy as jnp
from jax import lax
import numpy as np

D_MODEL = 1024
BATCH = 4
SEQ = 8192
DEPTH = 1

GRID_W = 64
CTX_LEN = 256
EXPAND = 2
D_MIX = EXPAND * D_MODEL
D_A = D_MIX // 2
D_B = D_MIX - D_A
HA_HEADS = 8
HA_DK = 128
HA_DV = D_A // HA_HEADS
A_QK = HA_HEADS * HA_DK
HB_HEADS = 8
HB_DK = 128
HB_DV = D_B // HB_HEADS
B_QK = HB_HEADS * HB_DK
CONV_K = 3
CONV_CH = 2 * B_QK + D_B
CHUNK = 64
NORM_EPS = 1e-6
COL_SIZES = (A_QK, A_QK, A_QK, D_A, D_A, B_QK, B_QK, D_B, D_B, 2 * HB_HEADS, 2 * HB_HEADS)
N_IN = 3 * A_QK + 2 * D_A + 2 * B_QK + 2 * D_B + 4 * HB_HEADS

kernel_name = "hybrid_hgrn2_gdn_flow_block"


def rmsnorm(x, w):
    xf = x.astype(jnp.float32)
    y = xf * lax.rsqrt(jnp.mean(xf * xf, axis=-1, keepdims=True) + NORM_EPS)
    return (y * w.astype(jnp.float32)).astype(x.dtype)


def l2norm(t):
    return t * lax.rsqrt(jnp.sum(t * t, axis=-1, keepdims=True) + NORM_EPS)


def heads(t, n_heads):
    bsz, length, width = t.shape
    return t.reshape(bsz, length, n_heads, width // n_heads).transpose(0, 2, 1, 3)


def merge_heads(t):
    bsz, nh, length, d = t.shape
    return t.transpose(0, 2, 1, 3).reshape(bsz, length, nh * d)


def split_columns(y):
    out, start = [], 0
    for size in COL_SIZES:
        out.append(y[..., start:start + size])
        start += size
    return out


def adaln(cond, ada_w, ada_b):
    m = jax.nn.silu(cond) @ ada_w + ada_b
    return jnp.split(m, 3, axis=-1)


def grid_conv(t, conv_w, rows):
    bsz, length, ch = t.shape
    img = t.reshape(bsz, rows, length // rows, ch)
    out = lax.conv_general_dilated(img, conv_w.astype(t.dtype)[:, :, None, :], (1, 1), "SAME",
                                   dimension_numbers=("NHWC", "HWIO", "NHWC"),
                                   feature_group_count=ch)
    return out.reshape(bsz, length, ch)


def hgrn2_scan(q, k, v, g, s0, readout):
    bsz, nh, length, dk = k.shape
    dv = v.shape[-1]
    n = length // CHUNK
    blk = lambda t: t.reshape(bsz, nh, n, CHUNK, t.shape[-1])
    q, k, v, g = blk(q), blk(k), blk(v), blk(g)
    b = jnp.cumsum(g, axis=-2)
    b_last = b[..., -1:, :]
    xs = [k * jnp.exp(b_last - b), v, jnp.exp(b_last)]
    if readout:
        xs += [q * jnp.exp(b), q, k, b]
    xs = tuple(jnp.moveaxis(t, 2, 0) for t in xs)
    incl = jnp.tril(jnp.ones((CHUNK, CHUNK), dtype=bool))[:, :, None]

    def step(s, inp):
        k_dec, v_i, d_last = inp[:3]
        s_new = d_last[..., 0, :, None] * s + jnp.einsum("bhsk,bhsv->bhkv", k_dec, v_i)
        if not readout:
            return s_new, None
        q_dec, q_i, k_i, b_i = inp[3:]
        diff = b_i[..., :, None, :] - b_i[..., None, :, :]
        dec = jnp.exp(jnp.where(incl, diff, -jnp.inf))
        scores = jnp.einsum("bhtk,bhsk,bhtsk->bhts", q_i, k_i, dec)
        o = jnp.einsum("bhtk,bhkv->bhtv", q_dec, s) + jnp.einsum("bhts,bhsv->bhtv", scores, v_i)
        return s_new, o

    s_fin, o = lax.scan(step, s0, xs)
    if readout:
        o = jnp.moveaxis(o, 0, 2).reshape(bsz, nh, length, dv)
    return o, s_fin


def gdn_scan(q, k, v, g, beta, s0, readout):
    bsz, nh, length, dk = k.shape
    dv = v.shape[-1]
    n = length // CHUNK
    blk = lambda t: t.reshape(bsz, nh, n, CHUNK, t.shape[-1])
    q, k, v = blk(q), blk(k), blk(v)
    g, beta = g.reshape(bsz, nh, n, CHUNK), beta.reshape(bsz, nh, n, CHUNK)
    b = jnp.cumsum(g, axis=-1)
    diff = b[..., :, None] - b[..., None, :]
    strict = jnp.tril(jnp.ones((CHUNK, CHUNK), dtype=bool), -1)
    incl = jnp.tril(jnp.ones((CHUNK, CHUNK), dtype=bool))
    kk = jnp.einsum("bhntk,bhnsk->bhnts", k, k)
    a_mat = jnp.eye(CHUNK, dtype=k.dtype) + beta[..., :, None] * kk * jnp.exp(jnp.where(strict, diff, -jnp.inf))
    rhs = jnp.concatenate([beta[..., None] * v, (beta * jnp.exp(b))[..., None] * k], axis=-1)
    sol = lax.linalg.triangular_solve(a_mat, rhs, left_side=True, lower=True, unit_diagonal=True)
    u0, w = sol[..., :dv], sol[..., dv:]
    b_last = b[..., -1:]
    xs = [u0, w, k * jnp.exp(b_last - b)[..., None], jnp.exp(b_last[..., 0])]
    if readout:
        p = jnp.einsum("bhntk,bhnsk->bhnts", q, k) * jnp.exp(jnp.where(incl, diff, -jnp.inf))
        xs += [q * jnp.exp(b)[..., None], p]
    xs = tuple(jnp.moveaxis(t, 2, 0) for t in xs)

    def step(s, inp):
        u0_i, w_i, k_dec, d_last = inp[:4]
        v_new = u0_i - jnp.einsum("bhck,bhkv->bhcv", w_i, s)
        s_new = d_last[..., None, None] * s + jnp.einsum("bhck,bhcv->bhkv", k_dec, v_new)
        if not readout:
            return s_new, None
        q_dec, p_i = inp[4:]
        o = jnp.einsum("bhtk,bhkv->bhtv", q_dec, s) + jnp.einsum("bhts,bhsv->bhtv", p_i, v_new)
        return s_new, o

    s_fin, o = lax.scan(step, s0, xs)
    if readout:
        o = jnp.moveaxis(o, 0, 2).reshape(bsz, nh, length, dv)
    return o, s_fin


def bidirectional(scan_fn, ctx_args, lat_args, s0, readout_ctx):
    flip = lambda t: jnp.flip(t, axis=2)
    (ctx_f, ctx_b), (lat_f, lat_b) = ctx_args, lat_args
    oc_f, sc_f = scan_fn(*ctx_f, s0, readout_ctx)
    oc_b, sc_b = scan_fn(*(flip(t) for t in ctx_b), s0, readout_ctx)
    ol_f, _ = scan_fn(*lat_f, sc_f, True)
    ol_b, _ = scan_fn(*(flip(t) for t in lat_b), sc_b, True)
    o_ctx = oc_f + flip(oc_b) if readout_ctx else None
    return ol_f + flip(ol_b), o_ctx


def project(h, w_in, conv_w, lb, a_log, dt_bias, rows):
    f32 = jnp.float32
    y = jnp.einsum("bld,dn->bln", h, w_in)
    a_q, a_f_fwd, a_f_bwd, a_i, a_z, b_q, b_k, b_v, b_z, b_a, b_b = split_columns(y)
    bsz, length, _ = y.shape
    q_a = heads(jax.nn.silu(a_q.astype(f32)), HA_HEADS) * HA_DK ** -0.5
    v_a = heads(a_i.astype(f32), HA_HEADS)

    def forget(fz, lb_d):
        fz = fz.astype(f32)
        log_f = jnp.logaddexp(jnp.log(lb_d), jnp.log1p(-lb_d) + jax.nn.log_sigmoid(fz))
        k = (1.0 - lb_d) * jax.nn.sigmoid(-fz)
        return heads(k, HA_HEADS), heads(log_f, HA_HEADS)

    k_af, g_af = forget(a_f_fwd, lb[0])
    k_ab, g_ab = forget(a_f_bwd, lb[1])
    hg_args = ((q_a, k_af, v_a, g_af), (q_a, k_ab, v_a, g_ab))
    qkv = jax.nn.silu(grid_conv(jnp.concatenate([b_q, b_k, b_v], axis=-1), conv_w, rows).astype(f32))
    q_b = l2norm(heads(qkv[..., :B_QK], HB_HEADS)) * HB_DK ** -0.5
    k_b = l2norm(heads(qkv[..., B_QK:2 * B_QK], HB_HEADS))
    v_b = heads(qkv[..., 2 * B_QK:], HB_HEADS)
    alpha_logit = b_a.astype(f32).reshape(bsz, length, 2, HB_HEADS)
    beta = jax.nn.sigmoid(b_b.astype(f32).reshape(bsz, length, 2, HB_HEADS))
    log_alpha = -jnp.exp(a_log.astype(f32)) * jax.nn.softplus(alpha_logit + dt_bias.astype(f32))
    log_alpha = log_alpha.transpose(2, 0, 3, 1)
    beta = beta.transpose(2, 0, 3, 1)
    gdn_args = ((q_b, k_b, v_b, log_alpha[0], beta[0]), (q_b, k_b, v_b, log_alpha[1], beta[1]))
    return hg_args, gdn_args, a_z.astype(f32), b_z.astype(f32)


def group_out(o_a, o_b, z_a, z_b, na_w, nb_w, w_out, dtype):
    def head_norm(o, w):
        o = o * lax.rsqrt(jnp.mean(o * o, axis=-1, keepdims=True) + NORM_EPS)
        return merge_heads(o * w.astype(jnp.float32)[None, :, None, :])

    y_a = jax.nn.silu(z_a) * head_norm(o_a, na_w)
    y_b = jax.nn.silu(z_b) * head_norm(o_b, nb_w)
    y = jnp.concatenate([y_a, y_b], axis=-1).astype(dtype)
    return y @ w_out


def setup_inputs(seed: int = 0) -> dict:
    key = jax.random.key(seed)
    ks = jax.random.split(key, 16)
    f32 = jnp.float32
    nrm = lambda k, shape, s: s * jax.random.normal(k, shape, f32)
    x = nrm(ks[0], (BATCH, SEQ, D_MODEL), 1.0)
    c = nrm(ks[1], (BATCH, D_MODEL), 1.0)
    ctx = nrm(ks[2], (BATCH, CTX_LEN, D_MODEL), 1.0)
    c_ctx = nrm(ks[3], (D_MODEL,), 1.0)
    norm_w = 1.0 + nrm(ks[4], (DEPTH, D_MODEL), 0.02)
    ada_w = nrm(ks[5], (DEPTH, D_MODEL, 3 * D_MODEL), 0.5 * D_MODEL ** -0.5)
    ada_b = nrm(ks[6], (DEPTH, 3 * D_MODEL), 0.01)
    w_in = nrm(ks[7], (DEPTH, D_MODEL, N_IN), D_MODEL ** -0.5)
    conv_w = nrm(ks[8], (DEPTH, CONV_K, CONV_K, CONV_CH), 1.0 / CONV_K)
    hg_lb_logits = nrm(ks[9], (DEPTH + 1, 2, A_QK), 0.5)
    gdn_a_log = jnp.log(jax.random.uniform(ks[10], (DEPTH, 2, HB_HEADS), f32, 1.0, 16.0))
    dt = jnp.exp(jax.random.uniform(ks[11], (DEPTH, 2, HB_HEADS), f32, math.log(1e-3), math.log(1e-1)))
    gdn_dt_bias = dt + jnp.log(-jnp.expm1(-dt))
    ha_norm_w = 1.0 + nrm(ks[12], (DEPTH, HA_HEADS, HA_DV), 0.02)
    hb_norm_w = 1.0 + nrm(ks[13], (DEPTH, HB_HEADS, HB_DV), 0.02)
    w_out = nrm(ks[14], (DEPTH, D_MIX, D_MODEL), D_MIX ** -0.5)
    final_norm_w = 1.0 + nrm(ks[15], (D_MODEL,), 0.02)
    return {"x": x, "c": c, "ctx": ctx, "c_ctx": c_ctx, "norm_w": norm_w, "ada_w": ada_w,
            "ada_b": ada_b, "w_in": w_in, "conv_w": conv_w, "hg_lb_logits": hg_lb_logits,
            "gdn_a_log": gdn_a_log, "gdn_dt_bias": gdn_dt_bias, "ha_norm_w": ha_norm_w,
            "hb_norm_w": hb_norm_w, "w_out": w_out, "final_norm_w": final_norm_w}


def reference(x, c, ctx, c_ctx, norm_w, ada_w, ada_b, w_in, conv_w, hg_lb_logits, gdn_a_log,
              gdn_dt_bias, ha_norm_w, hb_norm_w, w_out, final_norm_w):
    bsz = x.shape[0]
    rows = x.shape[1] // GRID_W
    lb_all = jnp.cumsum(jax.nn.softmax(hg_lb_logits.astype(jnp.float32), axis=0), axis=0)
    s0_a = jnp.zeros((bsz, HA_HEADS, HA_DK, HA_DV), jnp.float32)
    s0_b = jnp.zeros((bsz, HB_HEADS, HB_DK, HB_DV), jnp.float32)
    for layer in range(DEPTH):
        readout_ctx = layer + 1 < DEPTH
        sh_l, sc_l, gt_l = adaln(c, ada_w[layer], ada_b[layer])
        sh_c, sc_c, gt_c = adaln(c_ctx, ada_w[layer], ada_b[layer])
        h_lat = rmsnorm(x, norm_w[layer]) * (1.0 + sc_l[:, None, :]) + sh_l[:, None, :]
        h_ctx = rmsnorm(ctx, norm_w[layer]) * (1.0 + sc_c) + sh_c
        lat_hg, lat_gdn, lz_a, lz_b = project(h_lat, w_in[layer], conv_w[layer], lb_all[layer],
                                              gdn_a_log[layer], gdn_dt_bias[layer], rows)
        ctx_hg, ctx_gdn, cz_a, cz_b = project(h_ctx, w_in[layer], conv_w[layer], lb_all[layer],
                                              gdn_a_log[layer], gdn_dt_bias[layer], 1)
        oa_lat, oa_ctx = bidirectional(hgrn2_scan, ctx_hg, lat_hg, s0_a, readout_ctx)
        ob_lat, ob_ctx = bidirectional(gdn_scan, ctx_gdn, lat_gdn, s0_b, readout_ctx)
        mix_lat = group_out(oa_lat, ob_lat, lz_a, lz_b, ha_norm_w[layer], hb_norm_w[layer], w_out[layer], x.dtype)
        if readout_ctx:
            mix_ctx = group_out(oa_ctx, ob_ctx, cz_a, cz_b, ha_norm_w[layer], hb_norm_w[layer], w_out[layer], ctx.dtype)
            ctx = ctx + gt_c * mix_ctx
        x = x + gt_l[:, None, :] * mix_lat
    return rmsnorm(x, final_norm_w)
```

```cpp
#include <hip/hip_runtime.h>
#include <hip/hip_cooperative_groups.h>
#include <cstdio>
namespace cg = cooperative_groups;
__device__ __forceinline__ int tid_opaque() { int t = (int)threadIdx.x; asm volatile("" : "+v"(t)); return t; }
namespace pg8 {
#define PG8_LAS __attribute__((address_space(3)))
typedef unsigned short bf16_t;
typedef short bf16x8 __attribute__((ext_vector_type(8)));
typedef float f32x4 __attribute__((ext_vector_type(4)));
typedef unsigned u32x4 __attribute__((ext_vector_type(4)));
constexpr int BM = 256, BK = 64, HALF = 128, HTB = HALF * BK * 2  , STAGE_BYTES = 8 * HTB, NXCD = 8, WGM = 8;

__host__ __device__ __forceinline__ int lds_byte(int r, int c) { const int st = (r >> 4) * 2 + (c >> 5), rr = r & 15, cc = c & 31, ob = rr * 64 + cc * 2; return st * 1024 + (ob ^ (((ob >> 9) & 1) << 5)); }
__host__ __device__ __forceinline__ void stage_rc(int b, int& R, int& C) { const int st = b / 1024, sb = b % 1024, swz = sb ^ (((sb >> 9) & 1) << 5); R = (st >> 1) * 16 + swz / 64; C = (st & 1) * 32 + (swz % 64) / 2; }
__host__ __device__ __forceinline__ int perm32(int rho) { const int n = rho >> 4, i = rho & 15; return 8 * (i >> 2) + 4 * n + (i & 3); }

struct Unit { int pm, pn; };
struct Gemm { const bf16_t* A; const bf16_t* Bt; int M, N, K; };

struct StaticOrder {
    int nM, nN, nwg, G, c;
    __host__ __device__ void init(int M, int N, int G_, int c_) { nM = M / BM; nN = N / BM; nwg = nM * nN; G = G_; c = c_; }
    __host__ __device__ bool next(int i, Unit& u) const {
        const long L = (long)i * G + c; if (L >= nwg) return false;
        int wgid = (int)L; { const int q = nwg / NXCD, r = nwg % NXCD, xcd = wgid % NXCD, off = wgid / NXCD; wgid = (xcd < r ? xcd * (q + 1) : r * (q + 1) + (xcd - r) * q) + off; }
        const int nig = WGM * nN, gid = wgid / nig, fm = gid * WGM, gsz = (nM - fm) < WGM ? (nM - fm) : WGM;
        u.pm = fm + ((wgid % nig) % gsz); u.pn = (wgid % nig) / gsz; return true;
    }
    __device__ __forceinline__ void a_ready(const Unit&) const {}
    __device__ __forceinline__ void done(const Unit&) const {}
};

__device__ __forceinline__ unsigned cvt_pk_bf16(float lo, float hi) { unsigned r; asm volatile("v_cvt_pk_bf16_f32 %0, %1, %2" : "=v"(r) : "v"(lo), "v"(hi)); return r; }
typedef float f32x2 __attribute__((ext_vector_type(2)));

template <class Epi, class Sched, bool STAMP = false>
__device__ __forceinline__ void gemm_phase(PG8_LAS unsigned char* lds, const Gemm g, const Sched& S, const Epi& E, unsigned long long* stamps) {
    const int tid = ::tid_opaque(), wid = __builtin_amdgcn_readfirstlane(tid >> 6), lane = tid & 63, wr = wid >> 2, wc = wid & 3, fr = lane & 15, fq = lane >> 4;
    const int K = g.K, nt = K / BK;
    int ts_lo = 0, ts_hi = 0, nts = 0; const unsigned long long rt_entry = STAMP ? (unsigned long long)wall_clock64() : 0ull;
#define PG8_STAMP() do { if (STAMP && wid == 0 && nts < 64) { const unsigned long long _c = (unsigned long long)clock64(); \
        ts_lo = (lane == nts) ? (int)(unsigned)_c : ts_lo; ts_hi = (lane == nts) ? (int)(unsigned)(_c >> 32) : ts_hi; ++nts; } } while (0)
    PG8_STAMP();
    unsigned voffA[2], voffB[2];
#pragma unroll
    for (int i = 0; i < 2; ++i) { int R, C; stage_rc(tid * 16 + i * 8192, R, C); const int Rb = Epi::PERM ? ((R & ~31) + perm32(R & 31)) : R;
        voffA[i] = (unsigned)(R * K + C) * 2u; voffB[i] = (unsigned)(Rb * K + C) * 2u; }
    const size_t kstep = (size_t)(BK * 2);
    const size_t hstep = (size_t)HALF * K * 2;
    const size_t tstep = 2 * hstep;
    const unsigned ldsw = (unsigned)wid * 1024u;
    const int aoff = lds_byte(wr * 64 + fr, fq * 8), boff = lds_byte(wc * 32 + fr, fq * 8);
#define PG8_SA(b, h) (((b) * 2 + (h)) * HTB)
#define PG8_SB(b, h) ((4 + (b) * 2 + (h)) * HTB)
#define PG8_STAGE(bufoff, gbase, voff) do { _Pragma("unroll") for (int _i = 0; _i < 2; ++_i) \
        __builtin_amdgcn_global_load_lds((const unsigned*)((const char*)(gbase) + (voff)[_i]), (PG8_LAS unsigned*)(lds + (bufoff) + ldsw + _i * 8192), 16, 0, 0); } while (0)
#define PG8_LDA(dst, b, h) do { _Pragma("unroll") for (int m = 0; m < 4; ++m) _Pragma("unroll") for (int k = 0; k < 2; ++k) dst[m][k] = *(const PG8_LAS bf16x8*)(lds + PG8_SA(b, h) + aoff + m * 2048 + k * 1024); } while (0)
#define PG8_LDB(dst, b, h) do { _Pragma("unroll") for (int n = 0; n < 2; ++n) _Pragma("unroll") for (int k = 0; k < 2; ++k) dst[n][k] = *(const PG8_LAS bf16x8*)(lds + PG8_SB(b, h) + boff + n * 2048 + k * 1024); } while (0)
#define PG8_MMA(ai, bj, At, Bt) do { __builtin_amdgcn_s_setprio(1); _Pragma("unroll") for (int m = 0; m < 4; ++m) _Pragma("unroll") for (int n = 0; n < 2; ++n) _Pragma("unroll") for (int k = 0; k < 2; ++k) \
        acc[ai][bj][m][n] = __builtin_amdgcn_mfma_f32_16x16x32_bf16(Bt[n][k], At[m][k], acc[ai][bj][m][n], 0, 0, 0); __builtin_amdgcn_s_setprio(0); } while (0)
#define PG8_WAIT_V(n) asm volatile("s_waitcnt vmcnt(" #n ")" ::: "memory")
#define PG8_WAIT_L(n) asm volatile("s_waitcnt lgkmcnt(" #n ")" ::: "memory")
#define PG8_BAR __builtin_amdgcn_s_barrier()
#define PG8_SCHED __builtin_amdgcn_sched_barrier(0)
    Unit cur, nxt; int ui = 0;
    if (!S.next(0, cur)) return;
    f32x4 acc[2][2][4][2];
#pragma unroll
    for (int a = 0; a < 2; ++a)
#pragma unroll
        for (int b = 0; b < 2; ++b)
#pragma unroll
            for (int m = 0; m < 4; ++m)
#pragma unroll
                for (int n = 0; n < 2; ++n) acc[a][b][m][n] = (f32x4){0.f, 0.f, 0.f, 0.f};
    bf16x8 At[4][2], B0[2][2], B1[2][2];
    const char* cA = (const char*)g.A + (size_t)cur.pm * tstep; const char* cB = (const char*)g.Bt + (size_t)cur.pn * tstep;
    S.a_ready(cur);
    PG8_STAGE(PG8_SB(0, 0), cB, voffB); PG8_STAGE(PG8_SA(0, 0), cA, voffA); PG8_STAGE(PG8_SB(0, 1), cB + hstep, voffB); PG8_STAGE(PG8_SA(0, 1), cA + hstep, voffA);
    if (wr == 1) PG8_BAR;
    PG8_WAIT_V(4); PG8_BAR;
    PG8_STAGE(PG8_SB(1, 0), cB + kstep, voffB); PG8_STAGE(PG8_SA(1, 0), cA + kstep, voffA); PG8_STAGE(PG8_SB(1, 1), cB + hstep + kstep, voffB);
    PG8_WAIT_V(6); PG8_BAR;
    PG8_STAMP();
    for (;;) {
        const bool has_next = S.next(ui + 1, nxt);
        const char* nA = has_next ? (const char*)g.A + (size_t)nxt.pm * tstep : cA; const char* nB = has_next ? (const char*)g.Bt + (size_t)nxt.pn * tstep : cB;
        for (int t = 0; t < nt; t += 2) {
            const bool last = (t == nt - 2);
            const char* a1 = cA + (size_t)(t + 1) * kstep;
            const char* a2 = last ? nA : cA + (size_t)(t + 2) * kstep; const char* b2 = last ? nB : cB + (size_t)(t + 2) * kstep;
            const char* a3 = a2 + kstep; const char* b3 = b2 + kstep;
            if (last && has_next) S.a_ready(nxt);
            PG8_LDB(B0, 0, 0); PG8_SCHED; PG8_LDA(At, 0, 0); PG8_STAGE(PG8_SA(1, 1), a1 + hstep, voffA);
            PG8_WAIT_L(8); PG8_BAR; PG8_WAIT_L(0); PG8_MMA(0, 0, At, B0); PG8_BAR; PG8_SCHED;
            PG8_LDB(B1, 0, 1); PG8_STAGE(PG8_SB(0, 0), b2, voffB);
            PG8_BAR; PG8_WAIT_L(0); PG8_MMA(0, 1, At, B1); PG8_BAR;
            PG8_LDA(At, 0, 1); PG8_STAGE(PG8_SA(0, 0), a2, voffA);
            PG8_BAR; PG8_WAIT_L(0); PG8_MMA(1, 0, At, B0); PG8_BAR; PG8_SCHED;
            PG8_STAGE(PG8_SB(0, 1), b2 + hstep, voffB);
            PG8_WAIT_V(6); PG8_BAR; PG8_MMA(1, 1, At, B1); PG8_BAR;
            PG8_LDB(B0, 1, 0); PG8_SCHED; PG8_LDA(At, 1, 0); PG8_STAGE(PG8_SA(0, 1), a2 + hstep, voffA);
            PG8_WAIT_L(8); PG8_BAR; PG8_WAIT_L(0); PG8_MMA(0, 0, At, B0); PG8_BAR; PG8_SCHED;
            PG8_LDB(B1, 1, 1); PG8_STAGE(PG8_SB(1, 0), b3, voffB);
            PG8_BAR; PG8_WAIT_L(0); PG8_MMA(0, 1, At, B1); PG8_BAR;
            PG8_LDA(At, 1, 1); PG8_STAGE(PG8_SA(1, 0), a3, voffA);
            PG8_BAR; PG8_WAIT_L(0); PG8_MMA(1, 0, At, B0); PG8_BAR; PG8_SCHED;
            PG8_STAGE(PG8_SB(1, 1), b3 + hstep, voffB);
            PG8_WAIT_V(6); PG8_BAR; PG8_MMA(1, 1, At, B1); PG8_BAR;
        }
        PG8_STAMP();
        if constexpr (!Epi::AFTER_DRAIN) { E(acc, cur, wr, wc, fr, fq); S.done(cur); }
        PG8_STAMP();
        if (!has_next) break;
#pragma unroll
        for (int a = 0; a < 2; ++a)
#pragma unroll
            for (int b = 0; b < 2; ++b)
#pragma unroll
                for (int m = 0; m < 4; ++m)
#pragma unroll
                    for (int n = 0; n < 2; ++n) acc[a][b][m][n] = (f32x4){0.f, 0.f, 0.f, 0.f};
        cur = nxt; cA = nA; cB = nB; ++ui;
    }
    PG8_WAIT_V(0);
    if (wr == 0) PG8_BAR;
    PG8_BAR;
    if constexpr (Epi::AFTER_DRAIN) { E.fused(acc, cur, wr, wc, fr, fq, lds, wid, lane); S.done(cur); }
    PG8_STAMP();
    if (STAMP && wid == 0) { stamps[lane] = lane < nts ? (((unsigned long long)(unsigned)ts_hi << 32) | (unsigned)ts_lo) : 0ull;
        if (lane == 62) stamps[62] = rt_entry; if (lane == 63) stamps[63] = (unsigned long long)wall_clock64(); }
#undef PG8_STAMP
#undef PG8_SA
#undef PG8_SB
#undef PG8_STAGE
#undef PG8_LDA
#undef PG8_LDB
#undef PG8_MMA
#undef PG8_WAIT_V
#undef PG8_WAIT_L
#undef PG8_BAR
#undef PG8_SCHED
}
}

typedef unsigned short u16;
typedef unsigned int u32;
using pg8::f32x4;
using pg8::bf16x8;
using pg8::u32x4;

constexpr int D = 1024, NB = 4, SEQ = 8192, CTXL = 256, TOK = SEQ + CTXL;
constexpr int NIN = 9248;
constexpr int MP = 2 * TOK;
constexpr int MPL = 2 * SEQ;

struct Params {
  const float *x, *c, *ctx, *c_ctx, *norm_w, *ada_w, *ada_b, *w_in, *conv_w, *lb_logits, *a_log, *dt_bias, *ha_w, *hb_w, *w_out, *fnw;
  float* out;
  float* mod; float* lbv; u16* wtin; u16* wtout; u16* H; u16* YB; u16* YA; u16* YZ; float* AB; u16* QKVB;
};

__device__ __forceinline__ float bf2f(u32 b) { return __uint_as_float(b << 16); }
__device__ __forceinline__ u32 f2bf(float f) { u32 u = __float_as_uint(f); u += 0x7FFFu + ((u >> 16) & 1u); return u >> 16; }
__device__ __forceinline__ u32 pk2bf(float lo, float hi) { return f2bf(lo) | (f2bf(hi) << 16); }
__device__ __forceinline__ float h2f(u32 b) { return (float)__builtin_bit_cast(_Float16, (u16)b); }
__device__ __forceinline__ u32 f2h(float f) { return (u32)__builtin_bit_cast(u16, (_Float16)f); }
__device__ __forceinline__ float wave_sum(float v) {
#pragma unroll
  for (int o = 32; o >= 1; o >>= 1) v += __shfl_xor(v, o, 64);
  return v;
}
__device__ __forceinline__ float sigmoidf_(float x) { return 1.f / (1.f + __expf(-x)); }
__device__ __forceinline__ float siluf_(float x) { return x / (1.f + __expf(-x)); }

__device__ void transpose_tile(const float* __restrict__ src, int K, int N, u16* __restrict__ dst, int kt, int nt, float* tile) {
  const int tid = tid_opaque();
#pragma unroll
  for (int i = 0; i < 2; ++i) {
    const int kk = (tid >> 4) + 32 * i, n4 = (tid & 15) * 4, n = nt * 64 + n4;
    float4 v = make_float4(0.f, 0.f, 0.f, 0.f);
    if (n < N) v = *(const float4*)(src + (size_t)(kt * 64 + kk) * N + n);
    float* t = tile + kk * 65 + n4; t[0] = v.x; t[1] = v.y; t[2] = v.z; t[3] = v.w;
  }
  __syncthreads();
  {
    const int n = tid >> 3, k8 = (tid & 7) * 8;
    if (nt * 64 + n < N) {
      u32x4 w;
      w.x = pk2bf(tile[(k8 + 0) * 65 + n], tile[(k8 + 1) * 65 + n]);
      w.y = pk2bf(tile[(k8 + 2) * 65 + n], tile[(k8 + 3) * 65 + n]);
      w.z = pk2bf(tile[(k8 + 4) * 65 + n], tile[(k8 + 5) * 65 + n]);
      w.w = pk2bf(tile[(k8 + 6) * 65 + n], tile[(k8 + 7) * 65 + n]);
      *(u32x4*)(dst + (size_t)(nt * 64 + n) * K + kt * 64 + k8) = w;
    }
  }
  __syncthreads();
}

__device__ void phase0(const Params& p, unsigned char* smem) {
  const int tid = tid_opaque(), nb = gridDim.x, bid = blockIdx.x;
  float* sm = (float*)smem;
  constexpr int T_ADA = 48, T_WIN = 16 * 145, T_WOUT = 32 * 16;
  constexpr int NT = T_ADA + T_WIN + T_WOUT + 1;
  for (int task = bid; task < NT; task += nb) {
    if (task < T_ADA) {
      float* s_c = sm;
      float* s_red = sm + 5 * 1024;
      for (int i = tid; i < 5 * 1024; i += 512) { const int j = i >> 10, d = i & 1023; const float v = (j < 4) ? p.c[j * 1024 + d] : p.c_ctx[d]; s_c[i] = siluf_(v); }
      __syncthreads();
      const int cl = tid & 63, col = task * 64 + cl, ks = tid >> 6;
      float a0 = 0.f, a1 = 0.f, a2 = 0.f, a3 = 0.f, a4 = 0.f;
      const float* wp = p.ada_w + (size_t)(ks * 128) * 3072 + col;
#pragma unroll 8
      for (int d = 0; d < 128; ++d) {
        const float w = wp[(size_t)d * 3072]; const int dd = ks * 128 + d;
        a0 += s_c[dd] * w; a1 += s_c[1024 + dd] * w; a2 += s_c[2048 + dd] * w; a3 += s_c[3072 + dd] * w; a4 += s_c[4096 + dd] * w;
      }
      s_red[(ks * 5 + 0) * 64 + cl] = a0; s_red[(ks * 5 + 1) * 64 + cl] = a1; s_red[(ks * 5 + 2) * 64 + cl] = a2;
      s_red[(ks * 5 + 3) * 64 + cl] = a3; s_red[(ks * 5 + 4) * 64 + cl] = a4;
      __syncthreads();
      if (tid < 320) {
        const int j = tid >> 6, cc = tid & 63; float s = 0.f;
#pragma unroll
        for (int k = 0; k < 8; ++k) s += s_red[(k * 5 + j) * 64 + cc];
        p.mod[j * 3072 + task * 64 + cc] = s + p.ada_b[task * 64 + cc];
      }
      __syncthreads();
    } else if (task < T_ADA + T_WIN) {
      const int t = task - T_ADA; transpose_tile(p.w_in, 1024, NIN, p.wtin, t % 16, t / 16, sm);
    } else if (task < T_ADA + T_WIN + T_WOUT) {
      const int t = task - T_ADA - T_WIN; transpose_tile(p.w_out, 2048, 1024, p.wtout, t % 32, t / 32, sm);
    } else {
      for (int i = tid; i < 2048; i += 512) { const float l0 = p.lb_logits[i], l1 = p.lb_logits[2048 + i]; p.lbv[i] = 1.f / (1.f + __expf(l1 - l0)); }
    }
  }
}

__device__ void phase1(const Params& p, int pass) {
  const int tid = tid_opaque(), lane = tid & 63, gw = blockIdx.x * 8 + (tid >> 6), nw = gridDim.x * 8;
  for (int r = gw; r < MP; r += nw) {
    const int bl = r / TOK, tau = r - bl * TOK, b = pass * 2 + bl;
    const float* src; int j;
    if (tau < CTXL) { src = p.ctx + ((size_t)b * CTXL + tau) * D; j = 4; } else { src = p.x + ((size_t)b * SEQ + (tau - CTXL)) * D; j = b; }
    float4 v[4]; float ss = 0.f;
#pragma unroll
    for (int i = 0; i < 4; ++i) { v[i] = *(const float4*)(src + i * 256 + lane * 4); ss += v[i].x * v[i].x + v[i].y * v[i].y + v[i].z * v[i].z + v[i].w * v[i].w; }
    ss = wave_sum(ss);
    const float rstd = rsqrtf(ss * (1.f / 1024.f) + 1e-6f);
    const float* md = p.mod + j * 3072;
#pragma unroll
    for (int i = 0; i < 4; ++i) {
      const int d = i * 256 + lane * 4;
      const float4 nw4 = *(const float4*)(p.norm_w + d), sh = *(const float4*)(md + d), sc = *(const float4*)(md + 1024 + d);
      const float h0 = v[i].x * rstd * nw4.x * (1.f + sc.x) + sh.x, h1 = v[i].y * rstd * nw4.y * (1.f + sc.y) + sh.y;
      const float h2 = v[i].z * rstd * nw4.z * (1.f + sc.z) + sh.z, h3 = v[i].w * rstd * nw4.w * (1.f + sc.w) + sh.w;
      uint2 o; o.x = pk2bf(h0, h1); o.y = pk2bf(h2, h3);
      *(uint2*)(p.H + (size_t)r * D + d) = o;
    }
  }
}

template <int MODE> __device__ __forceinline__ void epi1_store(const f32x4 (&acc)[2][2][4][2], u16* base, int ld, int row0, int col0, const float* lbp) {
  float lb[2][8];
  if (MODE == 1) {
#pragma unroll
    for (int bj = 0; bj < 2; ++bj)
#pragma unroll
      for (int e = 0; e < 8; ++e) lb[bj][e] = lbp[col0 + bj * 128 + e];
  }
#pragma unroll
  for (int ai = 0; ai < 2; ++ai)
#pragma unroll
    for (int m = 0; m < 4; ++m) {
      u16* rowp = base + (size_t)(row0 + ai * 128 + m * 16) * ld + col0;
#pragma unroll
      for (int bj = 0; bj < 2; ++bj) {
        float v[8];
#pragma unroll
        for (int e = 0; e < 4; ++e) { v[e] = acc[ai][bj][m][0][e]; v[4 + e] = acc[ai][bj][m][1][e]; }
        u32 h[8];
#pragma unroll
        for (int e = 0; e < 8; ++e) {
          if (MODE == 0) h[e] = f2bf(siluf_(v[e]) * 0.08838834764831845f);
          else if (MODE == 1) { const float l = lb[bj][e]; const float f = l + (1.f - l) * sigmoidf_(v[e]); h[e] = f2h(__logf(f)); }
          else if (MODE == 2) h[e] = f2bf(v[e]);
          else h[e] = f2bf(siluf_(v[e]));
        }
        u32x4 w; w.x = h[0] | (h[1] << 16); w.y = h[2] | (h[3] << 16); w.z = h[4] | (h[5] << 16); w.w = h[6] | (h[7] << 16);
        *(u32x4*)(rowp + bj * 128) = w;
      }
    }
}

struct Epi1 {
  static constexpr bool PERM = true, AFTER_DRAIN = false;
  u16 *YA, *YZ, *YB; const float* lbv;
  __device__ __forceinline__ void operator()(const f32x4 (&acc)[2][2][4][2], const pg8::Unit& u, int wr, int wc, int fr, int fq) const {
    const int seg = u.pn >> 2, cseg = (u.pn & 3) * 256;
    const int row0 = u.pm * 256 + wr * 64 + fr, col0 = cseg + wc * 32 + 8 * fq;
    if (seg == 0) epi1_store<0>(acc, YA, 4096, row0, col0, lbv);
    else if (seg == 1) epi1_store<1>(acc, YA + 1024, 4096, row0, col0, lbv);
    else if (seg == 2) epi1_store<1>(acc, YA + 2048, 4096, row0, col0, lbv + 1024);
    else if (seg == 3) epi1_store<2>(acc, YA + 3072, 4096, row0, col0, lbv);
    else if (seg == 4) epi1_store<3>(acc, YZ, 2048, row0, col0, lbv);
    else if (seg <= 7) epi1_store<2>(acc, YB + (seg - 5) * 1024, 3072, row0, col0, lbv);
    else epi1_store<3>(acc, YZ + 1024, 2048, row0, col0, lbv);
  }
};

__device__ void phase2(const Params& p, unsigned char* smem) {
  {
    pg8::Gemm g; g.A = p.H; g.Bt = p.wtin; g.M = MP; g.N = 9216; g.K = 1024;
    pg8::StaticOrder S; S.init(g.M, g.N, (int)gridDim.x, (int)blockIdx.x);
    Epi1 E; E.YA = p.YA; E.YZ = p.YZ; E.YB = p.YB; E.lbv = p.lbv;
    pg8::gemm_phase<Epi1, pg8::StaticOrder, false>((PG8_LAS unsigned char*)smem, g, S, E, nullptr);
  }
  const int tid = tid_opaque(), lane = tid & 63, gw = blockIdx.x * 8 + (tid >> 6), nw = gridDim.x * 8;
  const int fr = lane & 15, quad = lane >> 4;
  for (int t = gw; t < MP / 16; t += nw) {
    f32x4 acc0 = {0.f, 0.f, 0.f, 0.f}, acc1 = {0.f, 0.f, 0.f, 0.f};
    const u16* ap = p.H + (size_t)(t * 16 + fr) * 1024 + quad * 8;
    const u16* b0 = p.wtin + (size_t)(9216 + fr) * 1024 + quad * 8;
    const u16* b1 = b0 + 16 * 1024;
#pragma unroll 4
    for (int k0 = 0; k0 < 1024; k0 += 32) {
      const bf16x8 a = *(const bf16x8*)(ap + k0), bb0 = *(const bf16x8*)(b0 + k0), bb1 = *(const bf16x8*)(b1 + k0);
      acc0 = __builtin_amdgcn_mfma_f32_16x16x32_bf16(a, bb0, acc0, 0, 0, 0);
      acc1 = __builtin_amdgcn_mfma_f32_16x16x32_bf16(a, bb1, acc1, 0, 0, 0);
    }
    const float ea = __expf(p.a_log[fr]), dtb = p.dt_bias[fr];
#pragma unroll
    for (int j = 0; j < 4; ++j) {
      const int r = t * 16 + quad * 4 + j;
      const float xx = acc0[j] + dtb;
      const float sp = xx > 20.f ? xx : log1pf(__expf(xx));
      p.AB[(size_t)r * 32 + fr] = -ea * sp;
      p.AB[(size_t)r * 32 + 16 + fr] = sigmoidf_(acc1[j]);
    }
  }
}

__device__ void phase3(const Params& p) {
  const int tid = tid_opaque();
  float w[3][9][2];
#pragma unroll
  for (int s = 0; s < 3; ++s)
#pragma unroll
    for (int t = 0; t < 9; ++t) { const float2 ww = *(const float2*)(p.conv_w + t * 3072 + s * 1024 + 2 * tid); w[s][t][0] = ww.x; w[s][t][1] = ww.y; }
  for (int r = blockIdx.x; r < MP; r += gridDim.x) {
    const int bl = r / TOK, tau = r - bl * TOK;
    float acc[3][2];
#pragma unroll
    for (int s = 0; s < 3; ++s) { acc[s][0] = 0.f; acc[s][1] = 0.f; }
    if (tau < CTXL) {
#pragma unroll
      for (int dw = 0; dw < 3; ++dw) {
        const int t2 = tau + dw - 1;
        if (t2 >= 0 && t2 < CTXL) {
          const u16* rp = p.YB + (size_t)(bl * TOK + t2) * 3072 + 2 * tid;
#pragma unroll
          for (int s = 0; s < 3; ++s) { const u32 q = *(const u32*)(rp + s * 1024); acc[s][0] += w[s][3 + dw][0] * bf2f(q & 0xFFFFu); acc[s][1] += w[s][3 + dw][1] * bf2f(q >> 16); }
        }
      }
    } else {
      const int sidx = tau - CTXL, rr = sidx >> 6, cc = sidx & 63;
#pragma unroll
      for (int dh = 0; dh < 3; ++dh)
#pragma unroll
        for (int dw = 0; dw < 3; ++dw) {
          const int r2 = rr + dh - 1, c2 = cc + dw - 1;
          if (r2 >= 0 && r2 < 128 && c2 >= 0 && c2 < 64) {
            const u16* rp = p.YB + (size_t)(bl * TOK + CTXL + r2 * 64 + c2) * 3072 + 2 * tid;
#pragma unroll
            for (int s = 0; s < 3; ++s) { const u32 q = *(const u32*)(rp + s * 1024); acc[s][0] += w[s][dh * 3 + dw][0] * bf2f(q & 0xFFFFu); acc[s][1] += w[s][dh * 3 + dw][1] * bf2f(q >> 16); }
          }
        }
    }
#pragma unroll
    for (int s = 0; s < 3; ++s) { acc[s][0] = siluf_(acc[s][0]); acc[s][1] = siluf_(acc[s][1]); }
    const float sq = wave_sum(acc[0][0] * acc[0][0] + acc[0][1] * acc[0][1]);
    const float sk = wave_sum(acc[1][0] * acc[1][0] + acc[1][1] * acc[1][1]);
    const float qs = rsqrtf(sq + 1e-6f) * 0.08838834764831845f, ks = rsqrtf(sk + 1e-6f);
    u16* op = p.QKVB + (size_t)r * 3072 + 2 * tid;
    *(u32*)(op) = pk2bf(acc[0][0] * qs, acc[0][1] * qs);
    *(u32*)(op + 1024) = pk2bf(acc[1][0] * ks, acc[1][1] * ks);
    *(u32*)(op + 2048) = pk2bf(acc[2][0], acc[2][1]);
  }
}

__device__ __forceinline__ int scan_tau(int dir, int i) { return dir == 0 ? i : (i < CTXL ? (CTXL - 1 - i) : (TOK + CTXL - 1 - i)); }

__device__ void scan_hgrn(const Params& p, int task, unsigned char* smem) {
  const int tid = tid_opaque();
  const int dir = task & 1, h = (task >> 1) & 7, bl = task >> 4;
  float* sq = (float*)smem;
  float* sf = sq + 16 * 144;
  float* sk = sf + 16 * 144;
  float* sv = sk + 16 * 144;
  const int v = tid >> 2, kg = tid & 3;
  float S[32];
#pragma unroll
  for (int j = 0; j < 32; ++j) S[j] = 0.f;
  u16* O = (u16*)p.H + (size_t)(0 * 2 + dir) * MPL * 1024;
  for (int i0 = 0; i0 < TOK; i0 += 16) {
    __syncthreads();
    {
      const int ti = tid >> 5, ch4 = (tid & 31) * 4;
      const int tau = scan_tau(dir, i0 + ti);
      const u16* rowp = p.YA + (size_t)(bl * TOK + tau) * 4096 + h * 128 + ch4;
      const uint2 qv = *(const uint2*)(rowp), gv = *(const uint2*)(rowp + 1024 + dir * 1024), vv = *(const uint2*)(rowp + 3072);
      const int o = ti * 144 + (ch4 >> 5) * 36 + (ch4 & 31);
      const float g0 = __expf(h2f(gv.x & 0xFFFFu)), g1 = __expf(h2f(gv.x >> 16)), g2 = __expf(h2f(gv.y & 0xFFFFu)), g3 = __expf(h2f(gv.y >> 16));
      sq[o] = bf2f(qv.x & 0xFFFFu); sq[o + 1] = bf2f(qv.x >> 16); sq[o + 2] = bf2f(qv.y & 0xFFFFu); sq[o + 3] = bf2f(qv.y >> 16);
      sf[o] = g0; sf[o + 1] = g1; sf[o + 2] = g2; sf[o + 3] = g3;
      sk[o] = 1.f - g0; sk[o + 1] = 1.f - g1; sk[o + 2] = 1.f - g2; sk[o + 3] = 1.f - g3;
      float* dv = sv + ti * 128 + ch4;
      dv[0] = bf2f(vv.x & 0xFFFFu); dv[1] = bf2f(vv.x >> 16); dv[2] = bf2f(vv.y & 0xFFFFu); dv[3] = bf2f(vv.y >> 16);
    }
    __syncthreads();
    for (int ti = 0; ti < 16; ++ti) {
      const int tau = scan_tau(dir, i0 + ti);
      const float vv = sv[ti * 128 + v];
      const float4* q4 = (const float4*)(sq + ti * 144 + kg * 36);
      const float4* f4 = (const float4*)(sf + ti * 144 + kg * 36);
      const float4* k4 = (const float4*)(sk + ti * 144 + kg * 36);
      float acc = 0.f;
#pragma unroll
      for (int j = 0; j < 8; ++j) {
        const float4 q = q4[j], f = f4[j], k = k4[j];
        S[4 * j + 0] = f.x * S[4 * j + 0] + k.x * vv; acc += q.x * S[4 * j + 0];
        S[4 * j + 1] = f.y * S[4 * j + 1] + k.y * vv; acc += q.y * S[4 * j + 1];
        S[4 * j + 2] = f.z * S[4 * j + 2] + k.z * vv; acc += q.z * S[4 * j + 2];
        S[4 * j + 3] = f.w * S[4 * j + 3] + k.w * vv; acc += q.w * S[4 * j + 3];
      }
      acc += __shfl_xor(acc, 1, 64); acc += __shfl_xor(acc, 2, 64);
      if (kg == 0 && tau >= CTXL) O[(size_t)(bl * SEQ + tau - CTXL) * 1024 + h * 128 + v] = (u16)f2bf(acc);
    }
  }
}

__device__ void scan_gdn(const Params& p, int task, unsigned char* smem) {
  const int tid = tid_opaque();
  const int vh = task & 1, dir = (task >> 1) & 1, h = (task >> 2) & 7, bl = task >> 5;
  float* sq = (float*)smem;
  float* sk = sq + 16 * 160;
  float* sv = sk + 16 * 160;
  float* sa = sv + 16 * 64;
  float* sb = sa + 16;
  const int v = tid >> 3, kg = tid & 7;
  float S[16];
#pragma unroll
  for (int j = 0; j < 16; ++j) S[j] = 0.f;
  u16* O = (u16*)p.H + (size_t)(1 * 2 + dir) * MPL * 1024;
  for (int i0 = 0; i0 < TOK; i0 += 16) {
    __syncthreads();
    {
      const int ti = tid >> 5, ch4 = (tid & 31) * 4;
      const int tau = scan_tau(dir, i0 + ti);
      const size_t row = (size_t)(bl * TOK + tau);
      const u16* rowp = p.QKVB + row * 3072 + h * 128;
      const uint2 qv = *(const uint2*)(rowp + ch4), kv = *(const uint2*)(rowp + 1024 + ch4);
      const u32 vv = *(const u32*)(rowp + 2048 + vh * 64 + (tid & 31) * 2);
      const int o = ti * 160 + (ch4 >> 4) * 20 + (ch4 & 15);
      sq[o] = bf2f(qv.x & 0xFFFFu); sq[o + 1] = bf2f(qv.x >> 16); sq[o + 2] = bf2f(qv.y & 0xFFFFu); sq[o + 3] = bf2f(qv.y >> 16);
      sk[o] = bf2f(kv.x & 0xFFFFu); sk[o + 1] = bf2f(kv.x >> 16); sk[o + 2] = bf2f(kv.y & 0xFFFFu); sk[o + 3] = bf2f(kv.y >> 16);
      sv[ti * 64 + (tid & 31) * 2] = bf2f(vv & 0xFFFFu); sv[ti * 64 + (tid & 31) * 2 + 1] = bf2f(vv >> 16);
      if (tid < 16) {
        const size_t row2 = (size_t)(bl * TOK + scan_tau(dir, i0 + tid));
        sa[tid] = __expf(p.AB[row2 * 32 + dir * 8 + h]); sb[tid] = p.AB[row2 * 32 + 16 + dir * 8 + h];
      }
    }
    __syncthreads();
    for (int ti = 0; ti < 16; ++ti) {
      const int tau = scan_tau(dir, i0 + ti);
      const float vv = sv[ti * 64 + v], a = sa[ti], be = sb[ti];
      const float4* q4 = (const float4*)(sq + ti * 160 + kg * 20);
      const float4* k4 = (const float4*)(sk + ti * 160 + kg * 20);
      float4 kk[4];
      float u = 0.f;
#pragma unroll
      for (int j = 0; j < 4; ++j) { kk[j] = k4[j]; u += kk[j].x * S[4 * j] + kk[j].y * S[4 * j + 1] + kk[j].z * S[4 * j + 2] + kk[j].w * S[4 * j + 3]; }
      u += __shfl_xor(u, 1, 64); u += __shfl_xor(u, 2, 64); u += __shfl_xor(u, 4, 64);
      const float wv = be * (vv - a * u);
      float acc = 0.f;
#pragma unroll
      for (int j = 0; j < 4; ++j) {
        const float4 q = q4[j];
        S[4 * j + 0] = a * S[4 * j + 0] + kk[j].x * wv; acc += q.x * S[4 * j + 0];
        S[4 * j + 1] = a * S[4 * j + 1] + kk[j].y * wv; acc += q.y * S[4 * j + 1];
        S[4 * j + 2] = a * S[4 * j + 2] + kk[j].z * wv; acc += q.z * S[4 * j + 2];
        S[4 * j + 3] = a * S[4 * j + 3] + kk[j].w * wv; acc += q.w * S[4 * j + 3];
      }
      acc += __shfl_xor(acc, 1, 64); acc += __shfl_xor(acc, 2, 64); acc += __shfl_xor(acc, 4, 64);
      if (kg == 0 && tau >= CTXL) O[(size_t)(bl * SEQ + tau - CTXL) * 1024 + h * 128 + vh * 64 + v] = (u16)f2bf(acc);
    }
  }
}

__device__ void phase4(const Params& p, unsigned char* smem) {
  for (int task = blockIdx.x; task < 96; task += gridDim.x) {
    if (task < 64) scan_gdn(p, task, smem); else scan_hgrn(p, task - 64, smem);
  }
}

__device__ void phase5(const Params& p) {
  const int tid = tid_opaque(), lane = tid & 63, gw = blockIdx.x * 8 + (tid >> 6), nw = gridDim.x * 8;
  const u16* O = (const u16*)p.H;
  u16* Yn = p.QKVB;
  for (int r = gw; r < MPL; r += nw) {
    const int bl = r >> 13, s = r & 8191;
    const size_t rowfull = (size_t)(bl * TOK + CTXL + s);
#pragma unroll 4
    for (int hh = 0; hh < 16; ++hh) {
      const int g = hh >> 3, h = hh & 7;
      const u32 a = *(const u32*)(O + ((size_t)(g * 2 + 0) * MPL + r) * 1024 + h * 128 + 2 * lane);
      const u32 b = *(const u32*)(O + ((size_t)(g * 2 + 1) * MPL + r) * 1024 + h * 128 + 2 * lane);
      const float o0 = bf2f(a & 0xFFFFu) + bf2f(b & 0xFFFFu), o1 = bf2f(a >> 16) + bf2f(b >> 16);
      const float ss = wave_sum(o0 * o0 + o1 * o1);
      const float rs = rsqrtf(ss * (1.f / 128.f) + 1e-6f);
      const float2 w = *(const float2*)((g ? p.hb_w : p.ha_w) + h * 128 + 2 * lane);
      const u32 z = *(const u32*)(p.YZ + rowfull * 2048 + g * 1024 + h * 128 + 2 * lane);
      *(u32*)(Yn + (size_t)r * 2048 + g * 1024 + h * 128 + 2 * lane) = pk2bf(bf2f(z & 0xFFFFu) * o0 * rs * w.x, bf2f(z >> 16) * o1 * rs * w.y);
    }
  }
}

struct Epi2 {
  static constexpr bool PERM = false, AFTER_DRAIN = false;
  const float* x; const float* mod; float* xn; int pass;
  __device__ __forceinline__ void operator()(const f32x4 (&acc)[2][2][4][2], const pg8::Unit& u, int wr, int wc, int fr, int fq) const {
    const int row0 = u.pm * 256 + wr * 64 + fr, col0 = u.pn * 256 + wc * 32 + 4 * fq;
    const int b = pass * 2 + (row0 >> 13);
    const float* gp = mod + b * 3072 + 2048 + col0;
    f32x4 gt[2][2];
#pragma unroll
    for (int bj = 0; bj < 2; ++bj)
#pragma unroll
      for (int n = 0; n < 2; ++n) gt[bj][n] = *(const f32x4*)(gp + bj * 128 + n * 16);
#pragma unroll
    for (int ai = 0; ai < 2; ++ai)
#pragma unroll
      for (int m = 0; m < 4; ++m) {
        const int r = row0 + ai * 128 + m * 16;
        const size_t grow = (size_t)b * SEQ + (r & 8191);
#pragma unroll
        for (int bj = 0; bj < 2; ++bj)
#pragma unroll
          for (int n = 0; n < 2; ++n) {
            const size_t off = grow * 1024 + col0 + bj * 128 + n * 16;
            const f32x4 xv = *(const f32x4*)(x + off);
            *(f32x4*)(xn + off) = xv + gt[bj][n] * acc[ai][bj][m][n];
          }
      }
  }
};

__device__ void phase6(const Params& p, int pass, unsigned char* smem) {
  pg8::Gemm g; g.A = p.QKVB; g.Bt = p.wtout; g.M = MPL; g.N = 1024; g.K = 2048;
  pg8::StaticOrder S; S.init(g.M, g.N, (int)gridDim.x, (int)blockIdx.x);
  Epi2 E; E.x = p.x; E.mod = p.mod; E.xn = p.out; E.pass = pass;
  pg8::gemm_phase<Epi2, pg8::StaticOrder, false>((PG8_LAS unsigned char*)smem, g, S, E, nullptr);
}

__device__ void phase7(const Params& p) {
  const int tid = tid_opaque(), lane = tid & 63, gw = blockIdx.x * 8 + (tid >> 6), nw = gridDim.x * 8;
  for (int r = gw; r < NB * SEQ; r += nw) {
    float* rp = p.out + (size_t)r * D;
    float4 v[4]; float ss = 0.f;
#pragma unroll
    for (int i = 0; i < 4; ++i) { v[i] = *(const float4*)(rp + i * 256 + lane * 4); ss += v[i].x * v[i].x + v[i].y * v[i].y + v[i].z * v[i].z + v[i].w * v[i].w; }
    ss = wave_sum(ss);
    const float rstd = rsqrtf(ss * (1.f / 1024.f) + 1e-6f);
#pragma unroll
    for (int i = 0; i < 4; ++i) {
      const float4 w = *(const float4*)(p.fnw + i * 256 + lane * 4);
      float4 o; o.x = v[i].x * rstd * w.x; o.y = v[i].y * rstd * w.y; o.z = v[i].z * rstd * w.z; o.w = v[i].w * rstd * w.w;
      *(float4*)(rp + i * 256 + lane * 4) = o;
    }
  }
}

__global__ void __launch_bounds__(512, 2) mega(Params p) {
  extern __shared__ __attribute__((aligned(16))) unsigned char smem[];
  cg::grid_group grid = cg::this_grid();
  phase0(p, smem);
  grid.sync();
  for (int pass = 0; pass < 2; ++pass) {
    Params q = p;
    {
      int z = 0; asm volatile("" : "+s"(z));
      q.x += z; q.ctx += z; q.mod += z; q.lbv += z; q.wtin += z; q.wtout += z; q.H += z; q.YB += z; q.YA += z; q.YZ += z; q.AB += z; q.QKVB += z; q.out += z;
      q.conv_w += z; q.norm_w += z;
    }
    phase1(q, pass);
    grid.sync();
    phase2(q, smem);
    grid.sync();
    phase3(q);
    grid.sync();
    phase4(q, smem);
    grid.sync();
    phase5(q);
    grid.sync();
    phase6(q, pass, smem);
  }
  grid.sync();
  phase7(p);
}

extern "C" void kernel_launch(void* const* d_in, const int* in_sizes, int n_in, void* d_out,
                              int out_size, void* d_ws, size_t ws_size, hipStream_t stream) {
  constexpr size_t kDynLds = 131072;
  static int grid_blocks = 0;
  if (!grid_blocks) {
    hipFuncSetAttribute((const void*)mega, hipFuncAttributeMaxDynamicSharedMemorySize, (int)kDynLds);
    int dev = 0, cus = 0, per_cu = 0;
    hipGetDevice(&dev);
    hipDeviceGetAttribute(&cus, hipDeviceAttributeMultiprocessorCount, dev);
    hipOccupancyMaxActiveBlocksPerMultiprocessor(&per_cu, mega, 512, kDynLds);
    if (per_cu > 1) per_cu = 1;
    grid_blocks = cus * per_cu;
  }
  Params p{};
  p.x = (const float*)d_in[0]; p.c = (const float*)d_in[1]; p.ctx = (const float*)d_in[2]; p.c_ctx = (const float*)d_in[3];
  p.norm_w = (const float*)d_in[4]; p.ada_w = (const float*)d_in[5]; p.ada_b = (const float*)d_in[6]; p.w_in = (const float*)d_in[7];
  p.conv_w = (const float*)d_in[8]; p.lb_logits = (const float*)d_in[9]; p.a_log = (const float*)d_in[10]; p.dt_bias = (const float*)d_in[11];
  p.ha_w = (const float*)d_in[12]; p.hb_w = (const float*)d_in[13]; p.w_out = (const float*)d_in[14]; p.fnw = (const float*)d_in[15];
  p.out = (float*)d_out;
  unsigned char* w = (unsigned char*)d_ws; size_t off = 0;
  auto take = [&](size_t bytes) { unsigned char* r = w + off; off += (bytes + 255) & ~(size_t)255; return r; };
  p.mod = (float*)take(5 * 3072 * 4);
  p.lbv = (float*)take(2048 * 4);
  p.wtin = (u16*)take((size_t)NIN * 1024 * 2);
  p.wtout = (u16*)take((size_t)1024 * 2048 * 2);
  p.H = (u16*)take((size_t)MP * 1024 * 2);
  p.YB = (u16*)take((size_t)MP * 3072 * 2);
  p.YA = (u16*)take((size_t)MP * 4096 * 2);
  p.YZ = (u16*)take((size_t)MP * 2048 * 2);
  p.AB = (float*)take((size_t)MP * 32 * 4);
  p.QKVB = (u16*)take((size_t)MP * 3072 * 2);
  void* args[] = {&p};
  hipError_t e = hipLaunchCooperativeKernel((void*)mega, dim3(grid_blocks), dim3(512), args, kDynLds, stream);
  if (e != hipSuccess) fprintf(stderr, "cooperative launch failed: %s (grid %d)\n", hipGetErrorString(e), grid_blocks);
}
```

```cpp
#include <hip/hip_runtime.h>
#include <hip/hip_cooperative_groups.h>
#include <cstdio>
namespace cg = cooperative_groups;
__device__ __forceinline__ int tid_opaque() { int t = (int)threadIdx.x; asm volatile("" : "+v"(t)); return t; }
__device__ __forceinline__ int bid_opaque() { int t = (int)blockIdx.x; asm volatile("" : "+s"(t)); return t; }
#include <hip/hip_runtime.h>
#include <cstdio>
#include <cstdint>
#include <cstdlib>
#include <vector>

#define XB_TMO      128
#define XB_XCNT(j)  (256  + 64 * (j))
#define XB_XSUB(j)  (1280 + 64 * (j))
#define XB_XGEN(j)  (2304 + 64 * (j))
#define XB_TOP      3328
#define XB_TOPGEN   3392
#define XCD_BAR_WORDS 3456
#define XB_SPIN_CAP (1u << 18)
#define LAS __attribute__((address_space(3)))

__device__ __forceinline__ unsigned xb_ld(unsigned* p)              { return __hip_atomic_load(p, __ATOMIC_RELAXED, __HIP_MEMORY_SCOPE_AGENT); }
__device__ __forceinline__ unsigned xb_add(unsigned* p, unsigned v) { return __hip_atomic_fetch_add(p, v, __ATOMIC_RELAXED, __HIP_MEMORY_SCOPE_AGENT); }
__device__ __forceinline__ unsigned xb_xcc_id() { return (unsigned)__builtin_amdgcn_s_getreg((3 << 11) | 20) & 0xFu; }
#define XB_SPIN(cond, bar) do { unsigned _sp = 0; while (cond) { __builtin_amdgcn_s_sleep(1); \
    if ((++_sp & 255u) == 0u) { if (xb_ld(&(bar)[XB_TMO])) break; if (_sp > XB_SPIN_CAP) { atomicAdd(&(bar)[XB_TMO], 1u); break; } } } } while (0)

struct XcdBarrier {
    unsigned* bar; unsigned x;
    volatile LAS unsigned* st;
};

__device__ __forceinline__ XcdBarrier xcd_barrier_post(unsigned* bar, volatile LAS unsigned* st) {
    XcdBarrier b; b.bar = bar; b.x = xb_xcc_id(); b.st = st;
    if (threadIdx.x == 0) (void)xb_add(&bar[XB_XCNT(b.x)], 1u);
    return b;
}
__device__ __forceinline__ void xcd_barrier_complete(unsigned* bar, unsigned x, unsigned& nloc, unsigned& nx) {
    const unsigned G = gridDim.x * gridDim.y * gridDim.z;
    unsigned sum, cnt, mine, sp = 0u;
    for (;;) {
        sum = 0u; cnt = 0u; mine = 0u;
#pragma unroll
        for (unsigned j = 0; j < 16; ++j) { const unsigned c = xb_ld(&bar[XB_XCNT(j)]); sum += c; cnt += (c > 0u) ? 1u : 0u; mine = (j == x) ? c : mine; }
        if (sum == G) break;
        __builtin_amdgcn_s_sleep(1);
        if ((++sp & 255u) == 0u) { if (xb_ld(&bar[XB_TMO])) break; if (sp > XB_SPIN_CAP) { atomicAdd(&bar[XB_TMO], 1u); break; } }
    }
    nloc = mine > 0u ? mine : 1u; nx = cnt > 0u ? cnt : 1u;
}

__device__ __forceinline__ void xcd_barrier(const XcdBarrier& b) {
    asm volatile("s_waitcnt vmcnt(0)" ::: "memory");
    __syncthreads();
    if (threadIdx.x == 0) {
        unsigned* bar = b.bar;
        __builtin_amdgcn_s_waitcnt(0);
        unsigned nloc = b.st[0], nx = b.st[1];
        if (nloc == 0u) { xcd_barrier_complete(bar, b.x, nloc, nx); b.st[0] = nloc; b.st[1] = nx; }
        const unsigned old = xb_add(&bar[XB_XSUB(b.x)], 1u);
        const unsigned gen = old / nloc;
        if (old + 1u == (gen + 1u) * nloc) {
            __builtin_amdgcn_fence(__ATOMIC_RELEASE, "agent");
            asm volatile("s_waitcnt vmcnt(0)" ::: "memory");
            const unsigned og = xb_add(&bar[XB_TOP], 1u);
            const unsigned tg = og / nx;
            if (og + 1u == (tg + 1u) * nx) xb_add(&bar[XB_TOPGEN], 1u);
            else XB_SPIN(xb_ld(&bar[XB_TOPGEN]) == tg, bar);
            __builtin_amdgcn_fence(__ATOMIC_ACQUIRE, "agent");
            xb_add(&bar[XB_XGEN(b.x)], 1u);
            asm volatile("s_waitcnt vmcnt(0)" ::: "memory");
        } else {
            XB_SPIN(xb_ld(&bar[XB_XGEN(b.x)]) == gen, bar);
            __builtin_amdgcn_fence(__ATOMIC_ACQUIRE, "agent");
            asm volatile("s_waitcnt vmcnt(0)" ::: "memory");
        }
    }
    __syncthreads();
}
namespace pg8 {
#define PG8_LAS __attribute__((address_space(3)))
typedef unsigned short bf16_t;
typedef short bf16x8 __attribute__((ext_vector_type(8)));
typedef float f32x4 __attribute__((ext_vector_type(4)));
typedef unsigned u32x4 __attribute__((ext_vector_type(4)));
constexpr int BM = 256, BK = 64, HALF = 128, HTB = HALF * BK * 2  , STAGE_BYTES = 8 * HTB, NXCD = 8, WGM = 8;

__host__ __device__ __forceinline__ int lds_byte(int r, int c) { const int st = (r >> 4) * 2 + (c >> 5), rr = r & 15, cc = c & 31, ob = rr * 64 + cc * 2; return st * 1024 + (ob ^ (((ob >> 9) & 1) << 5)); }
__host__ __device__ __forceinline__ void stage_rc(int b, int& R, int& C) { const int st = b / 1024, sb = b % 1024, swz = sb ^ (((sb >> 9) & 1) << 5); R = (st >> 1) * 16 + swz / 64; C = (st & 1) * 32 + (swz % 64) / 2; }
__host__ __device__ __forceinline__ int perm32(int rho) { const int n = rho >> 4, i = rho & 15; return 8 * (i >> 2) + 4 * n + (i & 3); }

struct Unit { int pm, pn; };
struct Gemm { const bf16_t* A; const bf16_t* Bt; int M, N, K; };

struct StaticOrder {
    int nM, nN, nwg, G, c;
    __host__ __device__ void init(int M, int N, int G_, int c_) { nM = M / BM; nN = N / BM; nwg = nM * nN; G = G_; c = c_; }
    __host__ __device__ bool next(int i, Unit& u) const {
        const long L = (long)i * G + c; if (L >= nwg) return false;
        int wgid = (int)L; { const int q = nwg / NXCD, r = nwg % NXCD, xcd = wgid % NXCD, off = wgid / NXCD; wgid = (xcd < r ? xcd * (q + 1) : r * (q + 1) + (xcd - r) * q) + off; }
        const int nig = WGM * nN, gid = wgid / nig, fm = gid * WGM, gsz = (nM - fm) < WGM ? (nM - fm) : WGM;
        u.pm = fm + ((wgid % nig) % gsz); u.pn = (wgid % nig) / gsz; return true;
    }
    __device__ __forceinline__ void a_ready(const Unit&) const {}
    __device__ __forceinline__ void done(const Unit&) const {}
};

__device__ __forceinline__ unsigned cvt_pk_bf16(float lo, float hi) { unsigned r; asm volatile("v_cvt_pk_bf16_f32 %0, %1, %2" : "=v"(r) : "v"(lo), "v"(hi)); return r; }
typedef float f32x2 __attribute__((ext_vector_type(2)));

template <class Epi, class Sched, bool STAMP = false>
__device__ __forceinline__ void gemm_phase(PG8_LAS unsigned char* lds, const Gemm g, const Sched& S, const Epi& E, unsigned long long* stamps) {
    const int tid = ::tid_opaque(), wid = __builtin_amdgcn_readfirstlane(tid >> 6), lane = tid & 63, wr = wid >> 2, wc = wid & 3, fr = lane & 15, fq = lane >> 4;
    const int K = g.K, nt = K / BK;
    int ts_lo = 0, ts_hi = 0, nts = 0; const unsigned long long rt_entry = STAMP ? (unsigned long long)wall_clock64() : 0ull;
#define PG8_STAMP() do { if (STAMP && wid == 0 && nts < 64) { const unsigned long long _c = (unsigned long long)clock64(); \
        ts_lo = (lane == nts) ? (int)(unsigned)_c : ts_lo; ts_hi = (lane == nts) ? (int)(unsigned)(_c >> 32) : ts_hi; ++nts; } } while (0)
    PG8_STAMP();
    unsigned voffA[2], voffB[2];
#pragma unroll
    for (int i = 0; i < 2; ++i) { int R, C; stage_rc(tid * 16 + i * 8192, R, C); const int Rb = Epi::PERM ? ((R & ~31) + perm32(R & 31)) : R;
        voffA[i] = (unsigned)(R * K + C) * 2u; voffB[i] = (unsigned)(Rb * K + C) * 2u; }
    const size_t kstep = (size_t)(BK * 2);
    const size_t hstep = (size_t)HALF * K * 2;
    const size_t tstep = 2 * hstep;
    const unsigned ldsw = (unsigned)wid * 1024u;
    const int aoff = lds_byte(wr * 64 + fr, fq * 8), boff = lds_byte(wc * 32 + fr, fq * 8);
#define PG8_SA(b, h) (((b) * 2 + (h)) * HTB)
#define PG8_SB(b, h) ((4 + (b) * 2 + (h)) * HTB)
#define PG8_STAGE(bufoff, gbase, voff) do { _Pragma("unroll") for (int _i = 0; _i < 2; ++_i) \
        __builtin_amdgcn_global_load_lds((const unsigned*)((const char*)(gbase) + (voff)[_i]), (PG8_LAS unsigned*)(lds + (bufoff) + ldsw + _i * 8192), 16, 0, 0); } while (0)
#define PG8_LDA(dst, b, h) do { _Pragma("unroll") for (int m = 0; m < 4; ++m) _Pragma("unroll") for (int k = 0; k < 2; ++k) dst[m][k] = *(const PG8_LAS bf16x8*)(lds + PG8_SA(b, h) + aoff + m * 2048 + k * 1024); } while (0)
#define PG8_LDB(dst, b, h) do { _Pragma("unroll") for (int n = 0; n < 2; ++n) _Pragma("unroll") for (int k = 0; k < 2; ++k) dst[n][k] = *(const PG8_LAS bf16x8*)(lds + PG8_SB(b, h) + boff + n * 2048 + k * 1024); } while (0)
#define PG8_MMA(ai, bj, At, Bt) do { __builtin_amdgcn_s_setprio(1); _Pragma("unroll") for (int m = 0; m < 4; ++m) _Pragma("unroll") for (int n = 0; n < 2; ++n) _Pragma("unroll") for (int k = 0; k < 2; ++k) \
        acc[ai][bj][m][n] = __builtin_amdgcn_mfma_f32_16x16x32_bf16(Bt[n][k], At[m][k], acc[ai][bj][m][n], 0, 0, 0); __builtin_amdgcn_s_setprio(0); } while (0)
#define PG8_WAIT_V(n) asm volatile("s_waitcnt vmcnt(" #n ")" ::: "memory")
#define PG8_WAIT_L(n) asm volatile("s_waitcnt lgkmcnt(" #n ")" ::: "memory")
#define PG8_BAR __builtin_amdgcn_s_barrier()
#define PG8_SCHED __builtin_amdgcn_sched_barrier(0)
    Unit cur, nxt; int ui = 0;
    if (!S.next(0, cur)) return;
    f32x4 acc[2][2][4][2];
#pragma unroll
    for (int a = 0; a < 2; ++a)
#pragma unroll
        for (int b = 0; b < 2; ++b)
#pragma unroll
            for (int m = 0; m < 4; ++m)
#pragma unroll
                for (int n = 0; n < 2; ++n) acc[a][b][m][n] = (f32x4){0.f, 0.f, 0.f, 0.f};
    bf16x8 At[4][2], B0[2][2], B1[2][2];
    const char* cA = (const char*)g.A + (size_t)cur.pm * tstep; const char* cB = (const char*)g.Bt + (size_t)cur.pn * tstep;
    S.a_ready(cur);
    PG8_STAGE(PG8_SB(0, 0), cB, voffB); PG8_STAGE(PG8_SA(0, 0), cA, voffA); PG8_STAGE(PG8_SB(0, 1), cB + hstep, voffB); PG8_STAGE(PG8_SA(0, 1), cA + hstep, voffA);
    if (wr == 1) PG8_BAR;
    PG8_WAIT_V(4); PG8_BAR;
    PG8_STAGE(PG8_SB(1, 0), cB + kstep, voffB); PG8_STAGE(PG8_SA(1, 0), cA + kstep, voffA); PG8_STAGE(PG8_SB(1, 1), cB + hstep + kstep, voffB);
    PG8_WAIT_V(6); PG8_BAR;
    PG8_STAMP();
    for (;;) {
        const bool has_next = S.next(ui + 1, nxt);
        const char* nA = has_next ? (const char*)g.A + (size_t)nxt.pm * tstep : cA; const char* nB = has_next ? (const char*)g.Bt + (size_t)nxt.pn * tstep : cB;
        for (int t = 0; t < nt; t += 2) {
            const bool last = (t == nt - 2);
            const char* a1 = cA + (size_t)(t + 1) * kstep;
            const char* a2 = last ? nA : cA + (size_t)(t + 2) * kstep; const char* b2 = last ? nB : cB + (size_t)(t + 2) * kstep;
            const char* a3 = a2 + kstep; const char* b3 = b2 + kstep;
            if (last && has_next) S.a_ready(nxt);
            PG8_LDB(B0, 0, 0); PG8_SCHED; PG8_LDA(At, 0, 0); PG8_STAGE(PG8_SA(1, 1), a1 + hstep, voffA);
            PG8_WAIT_L(8); PG8_BAR; PG8_WAIT_L(0); PG8_MMA(0, 0, At, B0); PG8_BAR; PG8_SCHED;
            PG8_LDB(B1, 0, 1); PG8_STAGE(PG8_SB(0, 0), b2, voffB);
            PG8_BAR; PG8_WAIT_L(0); PG8_MMA(0, 1, At, B1); PG8_BAR;
            PG8_LDA(At, 0, 1); PG8_STAGE(PG8_SA(0, 0), a2, voffA);
            PG8_BAR; PG8_WAIT_L(0); PG8_MMA(1, 0, At, B0); PG8_BAR; PG8_SCHED;
            PG8_STAGE(PG8_SB(0, 1), b2 + hstep, voffB);
            PG8_WAIT_V(6); PG8_BAR; PG8_MMA(1, 1, At, B1); PG8_BAR;
            PG8_LDB(B0, 1, 0); PG8_SCHED; PG8_LDA(At, 1, 0); PG8_STAGE(PG8_SA(0, 1), a2 + hstep, voffA);
            PG8_WAIT_L(8); PG8_BAR; PG8_WAIT_L(0); PG8_MMA(0, 0, At, B0); PG8_BAR; PG8_SCHED;
            PG8_LDB(B1, 1, 1); PG8_STAGE(PG8_SB(1, 0), b3, voffB);
            PG8_BAR; PG8_WAIT_L(0); PG8_MMA(0, 1, At, B1); PG8_BAR;
            PG8_LDA(At, 1, 1); PG8_STAGE(PG8_SA(1, 0), a3, voffA);
            PG8_BAR; PG8_WAIT_L(0); PG8_MMA(1, 0, At, B0); PG8_BAR; PG8_SCHED;
            PG8_STAGE(PG8_SB(1, 1), b3 + hstep, voffB);
            PG8_WAIT_V(6); PG8_BAR; PG8_MMA(1, 1, At, B1); PG8_BAR;
        }
        PG8_STAMP();
        if constexpr (!Epi::AFTER_DRAIN) { E(acc, cur, wr, wc, fr, fq); S.done(cur); }
        PG8_STAMP();
        if (!has_next) break;
#pragma unroll
        for (int a = 0; a < 2; ++a)
#pragma unroll
            for (int b = 0; b < 2; ++b)
#pragma unroll
                for (int m = 0; m < 4; ++m)
#pragma unroll
                    for (int n = 0; n < 2; ++n) acc[a][b][m][n] = (f32x4){0.f, 0.f, 0.f, 0.f};
        cur = nxt; cA = nA; cB = nB; ++ui;
    }
    PG8_WAIT_V(0);
    if (wr == 0) PG8_BAR;
    PG8_BAR;
    if constexpr (Epi::AFTER_DRAIN) { E.fused(acc, cur, wr, wc, fr, fq, lds, wid, lane); S.done(cur); }
    PG8_STAMP();
    if (STAMP && wid == 0) { stamps[lane] = lane < nts ? (((unsigned long long)(unsigned)ts_hi << 32) | (unsigned)ts_lo) : 0ull;
        if (lane == 62) stamps[62] = rt_entry; if (lane == 63) stamps[63] = (unsigned long long)wall_clock64(); }
#undef PG8_STAMP
#undef PG8_SA
#undef PG8_SB
#undef PG8_STAGE
#undef PG8_LDA
#undef PG8_LDB
#undef PG8_MMA
#undef PG8_WAIT_V
#undef PG8_WAIT_L
#undef PG8_BAR
#undef PG8_SCHED
}
}

typedef unsigned short u16;
typedef unsigned int u32;
using pg8::f32x4;
using pg8::bf16x8;
using pg8::u32x4;

constexpr int D = 1024, NB = 4, SEQ = 8192, CTXL = 256, TOK = SEQ + CTXL;
constexpr int NIN = 9248;
constexpr int MP = 2 * TOK;
constexpr int MPL = 2 * SEQ;

struct Params {
  const float *x, *c, *ctx, *c_ctx, *norm_w, *ada_w, *ada_b, *w_in, *conv_w, *lb_logits, *a_log, *dt_bias, *ha_w, *hb_w, *w_out, *fnw;
  float* out;
  unsigned char* ws;
};
constexpr size_t ws_up(size_t b) { return (b + 255) & ~(size_t)255; }
constexpr size_t OFF_mod = 0;
constexpr size_t OFF_lbv = OFF_mod + ws_up(5 * 3072 * 4);
constexpr size_t OFF_wtin = OFF_lbv + ws_up(2048 * 4);
constexpr size_t OFF_wtout = OFF_wtin + ws_up((size_t)NIN * 1024 * 2);
constexpr size_t OFF_H = OFF_wtout + ws_up((size_t)1024 * 2048 * 2);
constexpr size_t OFF_YB = OFF_H + ws_up((size_t)MP * 1024 * 2);
constexpr size_t OFF_YA = OFF_YB + ws_up((size_t)MP * 3072 * 2);
constexpr size_t OFF_YZ = OFF_YA + ws_up((size_t)MP * 4096 * 2);
constexpr size_t OFF_AB = OFF_YZ + ws_up((size_t)MP * 2048 * 2);
constexpr size_t OFF_QKVB = OFF_AB + ws_up((size_t)MP * 32 * 4);
constexpr size_t OFF_TPf = OFF_QKVB + ws_up((size_t)MP * 3072 * 2);
constexpr size_t OFF_TPb = OFF_TPf + ws_up((size_t)2112 * 4096 * 2);
constexpr size_t OFF_PPf = OFF_TPb + ws_up((size_t)2112 * 4096 * 2);
constexpr size_t OFF_GS = OFF_PPf + ws_up((size_t)2112 * 4096 * 2);
constexpr size_t OFF_DL = OFF_GS + ws_up((size_t)4224 * 256 * 4);
constexpr size_t OFF_bar = OFF_DL + ws_up((size_t)4224 * 128 * 4);
constexpr size_t WS_TOTAL = OFF_bar + ws_up((size_t)XCD_BAR_WORDS * 4);
#define WS_mod(p) ((float*)((p).ws + OFF_mod))
#define WS_lbv(p) ((float*)((p).ws + OFF_lbv))
#define WS_wtin(p) ((u16*)((p).ws + OFF_wtin))
#define WS_wtout(p) ((u16*)((p).ws + OFF_wtout))
#define WS_H(p) ((u16*)((p).ws + OFF_H))
#define WS_YB(p) ((u16*)((p).ws + OFF_YB))
#define WS_YA(p) ((u16*)((p).ws + OFF_YA))
#define WS_YZ(p) ((u16*)((p).ws + OFF_YZ))
#define WS_AB(p) ((float*)((p).ws + OFF_AB))
#define WS_QKVB(p) ((u16*)((p).ws + OFF_QKVB))
#define WS_TPf(p) ((u16*)((p).ws + OFF_TPf))
#define WS_TPb(p) ((u16*)((p).ws + OFF_TPb))
#define WS_PPf(p) ((u16*)((p).ws + OFF_PPf))
#define WS_GS(p) ((float*)((p).ws + OFF_GS))
#define WS_DL(p) ((float*)((p).ws + OFF_DL))
#define WS_bar(p) ((unsigned*)((p).ws + OFF_bar))


__device__ __forceinline__ float bf2f(u32 b) { return __uint_as_float(b << 16); }
typedef __bf16 hwbf16x2 __attribute__((ext_vector_type(2)));
typedef float hwf32x2 __attribute__((ext_vector_type(2)));
__device__ __forceinline__ u32 pk2bf(float lo, float hi) { const hwf32x2 v = {lo, hi}; return __builtin_bit_cast(u32, __builtin_convertvector(v, hwbf16x2)); }
__device__ __forceinline__ u32 f2bf(float f) { return pk2bf(f, f) & 0xFFFFu; }
__device__ __forceinline__ float h2f(u32 b) { return (float)__builtin_bit_cast(_Float16, (u16)b); }
__device__ __forceinline__ u32 f2h(float f) { return (u32)__builtin_bit_cast(u16, (_Float16)f); }
__device__ __forceinline__ float wave_sum(float v) {
#pragma unroll
  for (int o = 32; o >= 1; o >>= 1) v += __shfl_xor(v, o, 64);
  return v;
}
__device__ __forceinline__ float sigmoidf_(float x) { return __builtin_amdgcn_rcpf(1.f + __expf(-x)); }
__device__ __forceinline__ float siluf_(float x) { return x * __builtin_amdgcn_rcpf(1.f + __expf(-x)); }

__device__ void transpose_tile(const float* __restrict__ src, int K, int N, u16* __restrict__ dst, int kt, int nt, float* tile) {
  const int tid = tid_opaque();
#pragma unroll
  for (int i = 0; i < 2; ++i) {
    const int kk = (tid >> 4) + 32 * i, n4 = (tid & 15) * 4, n = nt * 64 + n4;
    float4 v = make_float4(0.f, 0.f, 0.f, 0.f);
    if (n < N) v = *(const float4*)(src + (size_t)(kt * 64 + kk) * N + n);
    float* t = tile + kk * 65 + n4; t[0] = v.x; t[1] = v.y; t[2] = v.z; t[3] = v.w;
  }
  __syncthreads();
  {
    const int n = tid >> 3, k8 = (tid & 7) * 8;
    if (nt * 64 + n < N) {
      u32x4 w;
      w.x = pk2bf(tile[(k8 + 0) * 65 + n], tile[(k8 + 1) * 65 + n]);
      w.y = pk2bf(tile[(k8 + 2) * 65 + n], tile[(k8 + 3) * 65 + n]);
      w.z = pk2bf(tile[(k8 + 4) * 65 + n], tile[(k8 + 5) * 65 + n]);
      w.w = pk2bf(tile[(k8 + 6) * 65 + n], tile[(k8 + 7) * 65 + n]);
      *(u32x4*)(dst + (size_t)(nt * 64 + n) * K + kt * 64 + k8) = w;
    }
  }
  __syncthreads();
}

__device__ void phase0(const Params& p, unsigned char* smem, int part) {
  const int tid = tid_opaque(), nb = gridDim.x, bid = bid_opaque();
  float* sm = (float*)smem;
  constexpr int T_ADA = 48, T_WIN = 16 * 145, T_WOUT = 32 * 16;
  constexpr int NT = T_ADA + T_WIN + T_WOUT + 1;
  for (int task = bid; task < NT; task += nb) {
    const bool isT = task >= T_ADA && task < T_ADA + T_WIN + T_WOUT;
    if (isT != (part == 1)) continue;
    if (task < T_ADA) {
      float* s_c = sm;
      float* s_red = sm + 5 * 1024;
      for (int i = tid; i < 5 * 1024; i += 512) { const int j = i >> 10, d = i & 1023; const float v = (j < 4) ? p.c[j * 1024 + d] : p.c_ctx[d]; s_c[i] = siluf_(v); }
      __syncthreads();
      const int cl = tid & 63, col = task * 64 + cl, ks = tid >> 6;
      float a0 = 0.f, a1 = 0.f, a2 = 0.f, a3 = 0.f, a4 = 0.f;
      const float* wp = p.ada_w + (size_t)(ks * 128) * 3072 + col;
#pragma unroll 1
      for (int d0 = 0; d0 < 128; d0 += 32) {
        float wv[32];
#pragma unroll
        for (int e = 0; e < 32; ++e) wv[e] = wp[(size_t)(d0 + e) * 3072];
#pragma unroll
        for (int e = 0; e < 32; ++e) { const float w = wv[e]; const int dd = ks * 128 + d0 + e;
          a0 += s_c[dd] * w; a1 += s_c[1024 + dd] * w; a2 += s_c[2048 + dd] * w; a3 += s_c[3072 + dd] * w; a4 += s_c[4096 + dd] * w; }
      }
      for (int d = 128; d < 128; ++d) {
        const float w = wp[(size_t)d * 3072]; const int dd = ks * 128 + d;
        a0 += s_c[dd] * w; a1 += s_c[1024 + dd] * w; a2 += s_c[2048 + dd] * w; a3 += s_c[3072 + dd] * w; a4 += s_c[4096 + dd] * w;
      }
      s_red[(ks * 5 + 0) * 64 + cl] = a0; s_red[(ks * 5 + 1) * 64 + cl] = a1; s_red[(ks * 5 + 2) * 64 + cl] = a2;
      s_red[(ks * 5 + 3) * 64 + cl] = a3; s_red[(ks * 5 + 4) * 64 + cl] = a4;
      __syncthreads();
      if (tid < 320) {
        const int j = tid >> 6, cc = tid & 63; float s = 0.f;
#pragma unroll
        for (int k = 0; k < 8; ++k) s += s_red[(k * 5 + j) * 64 + cc];
        WS_mod(p)[j * 3072 + task * 64 + cc] = s + p.ada_b[task * 64 + cc];
      }
      __syncthreads();
    } else if (task < T_ADA + T_WIN) {
      const int t = task - T_ADA; transpose_tile(p.w_in, 1024, NIN, WS_wtin(p), t % 16, t / 16, sm);
    } else if (task < T_ADA + T_WIN + T_WOUT) {
      const int t = task - T_ADA - T_WIN; transpose_tile(p.w_out, 2048, 1024, WS_wtout(p), t % 32, t / 32, sm);
    } else {
      for (int i = tid; i < 2048; i += 512) { const float l0 = p.lb_logits[i], l1 = p.lb_logits[2048 + i]; WS_lbv(p)[i] = 1.f / (1.f + __expf(l1 - l0)); }
    }
  }
}

__device__ void phase1(const Params& p, int pass) {
  const int tid = tid_opaque(), lane = tid & 63, gw = bid_opaque() * 8 + (tid >> 6), nw = gridDim.x * 8;
  for (int r = gw; r < MP; r += nw) {
    const int bl = r / TOK, tau = r - bl * TOK, b = pass * 2 + bl;
    const float* src; int j;
    if (tau < CTXL) { src = p.ctx + ((size_t)b * CTXL + tau) * D; j = 4; } else { src = p.x + ((size_t)b * SEQ + (tau - CTXL)) * D; j = b; }
    float4 v[4]; float ss = 0.f;
#pragma unroll
    for (int i = 0; i < 4; ++i) { v[i] = *(const float4*)(src + i * 256 + lane * 4); ss += v[i].x * v[i].x + v[i].y * v[i].y + v[i].z * v[i].z + v[i].w * v[i].w; }
    ss = wave_sum(ss);
    const float rstd = rsqrtf(ss * (1.f / 1024.f) + 1e-6f);
    const float* md = WS_mod(p) + j * 3072;
#pragma unroll
    for (int i = 0; i < 4; ++i) {
      const int d = i * 256 + lane * 4;
      const float4 nw4 = *(const float4*)(p.norm_w + d), sh = *(const float4*)(md + d), sc = *(const float4*)(md + 1024 + d);
      const float h0 = v[i].x * rstd * nw4.x * (1.f + sc.x) + sh.x, h1 = v[i].y * rstd * nw4.y * (1.f + sc.y) + sh.y;
      const float h2 = v[i].z * rstd * nw4.z * (1.f + sc.z) + sh.z, h3 = v[i].w * rstd * nw4.w * (1.f + sc.w) + sh.w;
      uint2 o; o.x = pk2bf(h0, h1); o.y = pk2bf(h2, h3);
      *(uint2*)(WS_H(p) + (size_t)r * D + d) = o;
    }
  }
}

template <int MODE> __device__ __forceinline__ void epi1_store(const f32x4 (&acc)[2][2][4][2], u16* base, int ld, int row0, int col0, const float* lbp) {
  float lb[2][8];
  if (MODE == 1) {
#pragma unroll
    for (int bj = 0; bj < 2; ++bj)
#pragma unroll
      for (int e = 0; e < 8; ++e) lb[bj][e] = lbp[col0 + bj * 128 + e];
  }
#pragma unroll
  for (int ai = 0; ai < 2; ++ai)
#pragma unroll
    for (int m = 0; m < 4; ++m) {
      u16* rowp = base + (size_t)(row0 + ai * 128 + m * 16) * ld + col0;
#pragma unroll
      for (int bj = 0; bj < 2; ++bj) {
        float v[8];
#pragma unroll
        for (int e = 0; e < 4; ++e) { v[e] = acc[ai][bj][m][0][e]; v[4 + e] = acc[ai][bj][m][1][e]; }
        float t[8];
#pragma unroll
        for (int e = 0; e < 8; ++e) {
          if (MODE == 0) t[e] = siluf_(v[e]) * 0.08838834764831845f;
          else if (MODE == 1) { const float l = lb[bj][e]; t[e] = __logf(l + (1.f - l) * sigmoidf_(v[e])); }
          else if (MODE == 2) t[e] = v[e];
          else t[e] = siluf_(v[e]);
        }
        u32x4 w;
        if (MODE == 1) { w.x = f2h(t[0]) | (f2h(t[1]) << 16); w.y = f2h(t[2]) | (f2h(t[3]) << 16); w.z = f2h(t[4]) | (f2h(t[5]) << 16); w.w = f2h(t[6]) | (f2h(t[7]) << 16); }
        else { w.x = pk2bf(t[0], t[1]); w.y = pk2bf(t[2], t[3]); w.z = pk2bf(t[4], t[5]); w.w = pk2bf(t[6], t[7]); }
        *(u32x4*)(rowp + bj * 128) = w;
      }
    }
}

struct Epi1 {
  static constexpr bool PERM = true, AFTER_DRAIN = false;
  u16 *YA, *YZ, *YB; const float* lbv;
  __device__ __forceinline__ void operator()(const f32x4 (&acc)[2][2][4][2], const pg8::Unit& u, int wr, int wc, int fr, int fq) const {
    const int seg = u.pn >> 2, cseg = (u.pn & 3) * 256;
    const int row0 = u.pm * 256 + wr * 64 + fr, col0 = cseg + wc * 32 + 8 * fq;
    if (seg == 0) epi1_store<0>(acc, YA, 4096, row0, col0, lbv);
    else if (seg == 1) epi1_store<1>(acc, YA + 1024, 4096, row0, col0, lbv);
    else if (seg == 2) epi1_store<1>(acc, YA + 2048, 4096, row0, col0, lbv + 1024);
    else if (seg == 3) epi1_store<2>(acc, YA + 3072, 4096, row0, col0, lbv);
    else if (seg == 4) epi1_store<3>(acc, YZ, 2048, row0, col0, lbv);
    else if (seg <= 7) epi1_store<2>(acc, YB + (seg - 5) * 1024, 3072, row0, col0, lbv);
    else epi1_store<3>(acc, YZ + 1024, 2048, row0, col0, lbv);
  }
};

__device__ void phase2(const Params& p, unsigned char* smem) {
  {
    pg8::Gemm g; g.A = WS_H(p); g.Bt = WS_wtin(p); g.M = MP; g.N = 9216; g.K = 1024;
    pg8::StaticOrder S; S.init(g.M, g.N, (int)gridDim.x, bid_opaque());
    Epi1 E; E.YA = WS_YA(p); E.YZ = WS_YZ(p); E.YB = WS_YB(p); E.lbv = WS_lbv(p);
    pg8::gemm_phase<Epi1, pg8::StaticOrder, false>((PG8_LAS unsigned char*)smem, g, S, E, nullptr);
  }
  const int tid = tid_opaque(), lane = tid & 63, gw = bid_opaque() * 8 + (tid >> 6), nw = gridDim.x * 8;
  const int fr = lane & 15, quad = lane >> 4;
  const int nbig = (MP / 256) * 36 - 9 * (int)gridDim.x;
  const bool bal = (gridDim.x == 256);
  if (bal && (int)(gw >> 3) < nbig) return;
  const int gw2 = bal ? gw - nbig * 8 : gw, nw2 = bal ? nw - nbig * 8 : nw;
  for (int t = gw2; t < MP / 16; t += nw2) {
    f32x4 acc0 = {0.f, 0.f, 0.f, 0.f}, acc1 = {0.f, 0.f, 0.f, 0.f};
    const u16* ap = WS_H(p) + (size_t)(t * 16 + fr) * 1024 + quad * 8;
    const u16* b0 = WS_wtin(p) + (size_t)(9216 + fr) * 1024 + quad * 8;
    const u16* b1 = b0 + 16 * 1024;
#pragma unroll 4
    for (int k0 = 0; k0 < 1024; k0 += 32) {
      const bf16x8 a = *(const bf16x8*)(ap + k0), bb0 = *(const bf16x8*)(b0 + k0), bb1 = *(const bf16x8*)(b1 + k0);
      acc0 = __builtin_amdgcn_mfma_f32_16x16x32_bf16(a, bb0, acc0, 0, 0, 0);
      acc1 = __builtin_amdgcn_mfma_f32_16x16x32_bf16(a, bb1, acc1, 0, 0, 0);
    }
    const float ea = __expf(p.a_log[fr]), dtb = p.dt_bias[fr];
#pragma unroll
    for (int j = 0; j < 4; ++j) {
      const int r = t * 16 + quad * 4 + j;
      const float xx = acc0[j] + dtb;
      const float sp = xx > 20.f ? xx : log1pf(__expf(xx));
      WS_AB(p)[(size_t)r * 32 + fr] = -ea * sp;
      WS_AB(p)[(size_t)r * 32 + 16 + fr] = sigmoidf_(acc1[j]);
    }
  }
}

__device__ __forceinline__ void conv_taps(int r, int nbr[9], float vm[9]) {
  const int bl = r / TOK, tau = r - bl * TOK;
#pragma unroll
  for (int dh = 0; dh < 3; ++dh)
#pragma unroll
    for (int dw = 0; dw < 3; ++dw) {
      bool valid; int nb;
      if (tau < CTXL) { const int t2 = tau + dw - 1; valid = (dh == 1) && t2 >= 0 && t2 < CTXL; nb = t2; }
      else { const int sidx = tau - CTXL, r2 = (sidx >> 6) + dh - 1, c2 = (sidx & 63) + dw - 1; valid = r2 >= 0 && r2 < 128 && c2 >= 0 && c2 < 64; nb = CTXL + r2 * 64 + c2; }
      nbr[dh * 3 + dw] = bl * TOK + (valid ? nb : tau);
      vm[dh * 3 + dw] = valid ? 1.f : 0.f;
    }
}

__device__ void phase3(const Params& p, unsigned char* smem) {
  const int tid = tid_opaque();
  u16* T = (u16*)smem;
  const int cg = tid & 15, tk0 = tid >> 4;
  constexpr int NTASK = 2 * 33 * 24;
  float* sW = (float*)(T + 6 * 66 * 128);
  u32x4 pre[12]; u32x4 preh = {0u, 0u, 0u, 0u}; float4 prew = make_float4(0.f, 0.f, 0.f, 0.f);
  auto decode = [&](int task, int& bl, int& g, int& seg, int& head) { const int sh = task % 24; g = (task / 24) % 33; bl = task / (24 * 33); seg = sh >> 3; head = sh & 7; };
  auto issue = [&](int task) {
    int bl, g, seg, head; decode(task, bl, g, seg, head);
    const u16* base = WS_YB(p) + (size_t)bl * TOK * 3072 + seg * 1024 + head * 128;
#pragma unroll
    for (int j = 0; j < 12; ++j) {
      const int piece = tid + 512 * j, dh = piece >> 10, c = (piece >> 4) & 63, ch = piece & 15;
      const int m = 4 * g + dh - 1;
      const bool valid = (g == 0) ? (m >= 0 && m < 4) : (m >= 4 && m < 132);
      pre[j] = (u32x4){0u, 0u, 0u, 0u};
      if (valid) pre[j] = *(const u32x4*)(base + (size_t)(64 * m + c) * 3072 + ch * 8);
    }
    if (tid < 288) prew = *(const float4*)(p.conv_w + (tid >> 5) * 3072 + seg * 1024 + head * 128 + (tid & 31) * 4);
    preh = (u32x4){0u, 0u, 0u, 0u};
    if (tid < 128 && g == 0) {
      const int row = tid >> 5, side = (tid >> 4) & 1, tok = side ? 64 * row + 64 : 64 * row - 1;
      if (tok >= 0 && tok < CTXL) preh = *(const u32x4*)(base + (size_t)tok * 3072 + (tid & 15) * 8);
    }
  };
  auto stage = [&]() {
#pragma unroll
    for (int j = 0; j < 12; ++j) { const int piece = tid + 512 * j, dh = piece >> 10, c = (piece >> 4) & 63, ch = piece & 15; *(u32x4*)(T + ((dh * 66 + c + 1) * 128 + ch * 8)) = pre[j]; }
    if (tid < 288) *(float4*)(sW + (tid >> 5) * 128 + (tid & 31) * 4) = prew;
    if (tid < 128) {
      const int row = tid >> 5, side = (tid >> 4) & 1, ch = tid & 15;
      *(u32x4*)(T + (((row + 1) * 66 + side * 65) * 128 + ch * 8)) = preh;
    } else if (tid < 192) {
      const int u = tid - 128, dh = (u >> 5) * 5, side = (u >> 4) & 1, ch = u & 15;
      *(u32x4*)(T + ((dh * 66 + side * 65) * 128 + ch * 8)) = (u32x4){0u, 0u, 0u, 0u};
    }
  };
  int task = bid_opaque();
  if (task < NTASK) issue(task);
  for (; task < NTASK; task += gridDim.x) {
    int bl, g, seg, head; decode(task, bl, g, seg, head);
    __syncthreads();
    stage();
    float w[9][8];
    const float rowm = g == 0 ? 0.f : 1.f;
    __syncthreads();
#pragma unroll
    for (int t = 0; t < 9; ++t) {
      const float* wp = sW + t * 128 + cg * 8;
      const float4 a = *(const float4*)wp, b = *(const float4*)(wp + 4);
      const float m = (t >= 3 && t < 6) ? 1.f : rowm;
      w[t][0] = a.x * m; w[t][1] = a.y * m; w[t][2] = a.z * m; w[t][3] = a.w * m; w[t][4] = b.x * m; w[t][5] = b.y * m; w[t][6] = b.z * m; w[t][7] = b.w * m;
    }
    if (task + (int)gridDim.x < NTASK) issue(task + gridDim.x);
#pragma unroll 2
    for (int kk = 0; kk < 8; ++kk) {
      const int row = kk >> 1, t = tk0 + 32 * (kk & 1);
      float acc[8];
#pragma unroll
      for (int e = 0; e < 8; ++e) acc[e] = 0.f;
#pragma unroll
      for (int dh = 0; dh < 3; ++dh)
#pragma unroll
        for (int dw = 0; dw < 3; ++dw) {
          const u32x4 q = *(const u32x4*)(T + (((row + dh) * 66 + t + dw) * 128 + cg * 8));
#pragma unroll
          for (int e = 0; e < 4; ++e) { acc[2 * e] += w[dh * 3 + dw][2 * e] * bf2f(q[e] & 0xFFFFu); acc[2 * e + 1] += w[dh * 3 + dw][2 * e + 1] * bf2f(q[e] >> 16); }
        }
      float ss = 0.f;
#pragma unroll
      for (int e = 0; e < 8; ++e) { acc[e] = siluf_(acc[e]); ss += acc[e] * acc[e]; }
      ss += __shfl_xor(ss, 1, 64); ss += __shfl_xor(ss, 2, 64); ss += __shfl_xor(ss, 4, 64); ss += __shfl_xor(ss, 8, 64);
      const float sc = seg == 2 ? 1.f : rsqrtf(ss + 1e-6f) * (seg == 0 ? 0.08838834764831845f : 1.f);
      u32x4 o;
#pragma unroll
      for (int e = 0; e < 4; ++e) o[e] = pk2bf(acc[2 * e] * sc, acc[2 * e + 1] * sc);
      *(u32x4*)(WS_QKVB(p) + (size_t)(bl * TOK + 64 * (4 * g + row) + t) * 3072 + seg * 1024 + head * 128 + cg * 8) = o;
    }
  }
  __syncthreads();
}

__device__ __forceinline__ int scan_tau(int dir, int i) { return dir == 0 ? i : (i < CTXL ? (CTXL - 1 - i) : (TOK + CTXL - 1 - i)); }

__device__ void scan_hgrn(const Params& p, int task, unsigned char* smem) {
  const int tid = tid_opaque();
  const int dir = task & 1, h = (task >> 1) & 7, bl = task >> 4;
  float* sq = (float*)smem;
  float* sf = sq + 16 * 144;
  float* sk = sf + 16 * 144;
  float* sv = sk + 16 * 144;
  const int v = tid >> 2, kg = tid & 3;
  float S[32];
#pragma unroll
  for (int j = 0; j < 32; ++j) S[j] = 0.f;
  u16* O = (u16*)WS_H(p) + (size_t)(0 * 2 + dir) * MPL * 1024;
  for (int i0 = 0; i0 < TOK; i0 += 16) {
    __syncthreads();
    {
      const int ti = tid >> 5, ch4 = (tid & 31) * 4;
      const int tau = scan_tau(dir, i0 + ti);
      const u16* rowp = WS_YA(p) + (size_t)(bl * TOK + tau) * 4096 + h * 128 + ch4;
      const uint2 qv = *(const uint2*)(rowp), gv = *(const uint2*)(rowp + 1024 + dir * 1024), vv = *(const uint2*)(rowp + 3072);
      const int o = ti * 144 + (ch4 >> 5) * 36 + (ch4 & 31);
      const float g0 = __expf(h2f(gv.x & 0xFFFFu)), g1 = __expf(h2f(gv.x >> 16)), g2 = __expf(h2f(gv.y & 0xFFFFu)), g3 = __expf(h2f(gv.y >> 16));
      sq[o] = bf2f(qv.x & 0xFFFFu); sq[o + 1] = bf2f(qv.x >> 16); sq[o + 2] = bf2f(qv.y & 0xFFFFu); sq[o + 3] = bf2f(qv.y >> 16);
      sf[o] = g0; sf[o + 1] = g1; sf[o + 2] = g2; sf[o + 3] = g3;
      sk[o] = 1.f - g0; sk[o + 1] = 1.f - g1; sk[o + 2] = 1.f - g2; sk[o + 3] = 1.f - g3;
      float* dv = sv + ti * 128 + ch4;
      dv[0] = bf2f(vv.x & 0xFFFFu); dv[1] = bf2f(vv.x >> 16); dv[2] = bf2f(vv.y & 0xFFFFu); dv[3] = bf2f(vv.y >> 16);
    }
    __syncthreads();
    for (int ti = 0; ti < 16; ++ti) {
      const int tau = scan_tau(dir, i0 + ti);
      const float vv = sv[ti * 128 + v];
      const float4* q4 = (const float4*)(sq + ti * 144 + kg * 36);
      const float4* f4 = (const float4*)(sf + ti * 144 + kg * 36);
      const float4* k4 = (const float4*)(sk + ti * 144 + kg * 36);
      float acc = 0.f;
#pragma unroll
      for (int j = 0; j < 8; ++j) {
        const float4 q = q4[j], f = f4[j], k = k4[j];
        S[4 * j + 0] = f.x * S[4 * j + 0] + k.x * vv; acc += q.x * S[4 * j + 0];
        S[4 * j + 1] = f.y * S[4 * j + 1] + k.y * vv; acc += q.y * S[4 * j + 1];
        S[4 * j + 2] = f.z * S[4 * j + 2] + k.z * vv; acc += q.z * S[4 * j + 2];
        S[4 * j + 3] = f.w * S[4 * j + 3] + k.w * vv; acc += q.w * S[4 * j + 3];
      }
      acc += __shfl_xor(acc, 1, 64); acc += __shfl_xor(acc, 2, 64);
      if (kg == 0 && tau >= CTXL) O[(size_t)(bl * SEQ + tau - CTXL) * 1024 + h * 128 + v] = (u16)f2bf(acc);
    }
  }
}

__device__ void scan_gdn(const Params& p, int task, unsigned char* smem) {
  const int tid = tid_opaque();
  const int vh = task & 1, dir = (task >> 1) & 1, h = (task >> 2) & 7, bl = task >> 5;
  float* sq = (float*)smem;
  float* sk = sq + 16 * 160;
  float* sv = sk + 16 * 160;
  float* sa = sv + 16 * 64;
  float* sb = sa + 16;
  const int v = tid >> 3, kg = tid & 7;
  float S[16];
#pragma unroll
  for (int j = 0; j < 16; ++j) S[j] = 0.f;
  u16* O = (u16*)WS_H(p) + (size_t)(1 * 2 + dir) * MPL * 1024;
  for (int i0 = 0; i0 < TOK; i0 += 16) {
    __syncthreads();
    {
      const int ti = tid >> 5, ch4 = (tid & 31) * 4;
      const int tau = scan_tau(dir, i0 + ti);
      const size_t row = (size_t)(bl * TOK + tau);
      const u16* rowp = WS_QKVB(p) + row * 3072 + h * 128;
      const uint2 qv = *(const uint2*)(rowp + ch4), kv = *(const uint2*)(rowp + 1024 + ch4);
      const u32 vv = *(const u32*)(rowp + 2048 + vh * 64 + (tid & 31) * 2);
      const int o = ti * 160 + (ch4 >> 4) * 20 + (ch4 & 15);
      sq[o] = bf2f(qv.x & 0xFFFFu); sq[o + 1] = bf2f(qv.x >> 16); sq[o + 2] = bf2f(qv.y & 0xFFFFu); sq[o + 3] = bf2f(qv.y >> 16);
      sk[o] = bf2f(kv.x & 0xFFFFu); sk[o + 1] = bf2f(kv.x >> 16); sk[o + 2] = bf2f(kv.y & 0xFFFFu); sk[o + 3] = bf2f(kv.y >> 16);
      sv[ti * 64 + (tid & 31) * 2] = bf2f(vv & 0xFFFFu); sv[ti * 64 + (tid & 31) * 2 + 1] = bf2f(vv >> 16);
      if (tid < 16) {
        const size_t row2 = (size_t)(bl * TOK + scan_tau(dir, i0 + tid));
        sa[tid] = __expf(WS_AB(p)[row2 * 32 + dir * 8 + h]); sb[tid] = WS_AB(p)[row2 * 32 + 16 + dir * 8 + h];
      }
    }
    __syncthreads();
    for (int ti = 0; ti < 16; ++ti) {
      const int tau = scan_tau(dir, i0 + ti);
      const float vv = sv[ti * 64 + v], a = sa[ti], be = sb[ti];
      const float4* q4 = (const float4*)(sq + ti * 160 + kg * 20);
      const float4* k4 = (const float4*)(sk + ti * 160 + kg * 20);
      float4 kk[4];
      float u = 0.f;
#pragma unroll
      for (int j = 0; j < 4; ++j) { kk[j] = k4[j]; u += kk[j].x * S[4 * j] + kk[j].y * S[4 * j + 1] + kk[j].z * S[4 * j + 2] + kk[j].w * S[4 * j + 3]; }
      u += __shfl_xor(u, 1, 64); u += __shfl_xor(u, 2, 64); u += __shfl_xor(u, 4, 64);
      const float wv = be * (vv - a * u);
      float acc = 0.f;
#pragma unroll
      for (int j = 0; j < 4; ++j) {
        const float4 q = q4[j];
        S[4 * j + 0] = a * S[4 * j + 0] + kk[j].x * wv; acc += q.x * S[4 * j + 0];
        S[4 * j + 1] = a * S[4 * j + 1] + kk[j].y * wv; acc += q.y * S[4 * j + 1];
        S[4 * j + 2] = a * S[4 * j + 2] + kk[j].z * wv; acc += q.z * S[4 * j + 2];
        S[4 * j + 3] = a * S[4 * j + 3] + kk[j].w * wv; acc += q.w * S[4 * j + 3];
      }
      acc += __shfl_xor(acc, 1, 64); acc += __shfl_xor(acc, 2, 64); acc += __shfl_xor(acc, 4, 64);
      if (kg == 0 && tau >= CTXL) O[(size_t)(bl * SEQ + tau - CTXL) * 1024 + h * 128 + vh * 64 + v] = (u16)f2bf(acc);
    }
  }
}


typedef float f32x16 __attribute__((ext_vector_type(16)));
typedef short s16x4 __attribute__((ext_vector_type(4)));
#define MFMA32(a, b, c) __builtin_amdgcn_mfma_f32_32x32x16_bf16((a), (b), (c), 0, 0, 0)
__device__ __forceinline__ int crow(int reg, int h) { return (reg & 3) + 8 * (reg >> 2) + 4 * h; }
__device__ __forceinline__ bf16x8 pack8(const f32x16& x, int s) {
  u32x4 w; w.x = pk2bf(x[8 * s + 0], x[8 * s + 1]); w.y = pk2bf(x[8 * s + 2], x[8 * s + 3]); w.z = pk2bf(x[8 * s + 4], x[8 * s + 5]); w.w = pk2bf(x[8 * s + 6], x[8 * s + 7]);
  return __builtin_bit_cast(bf16x8, w);
}
__device__ __forceinline__ bf16x8 cat4(s16x4 lo, s16x4 hi) { return __builtin_shufflevector(lo, hi, 0, 1, 2, 3, 4, 5, 6, 7); }
__device__ __forceinline__ bf16x8 ld_perm(const u16* p, int h) { return cat4(*(const s16x4*)(p + 4 * h), *(const s16x4*)(p + 8 + 4 * h)); }
__device__ __forceinline__ s16x4 tr_rd(const u16* p) { return __builtin_amdgcn_ds_read_tr16_b64_v4i16((__attribute__((address_space(3))) s16x4*)p); }

template <int DIR> __device__ __forceinline__ void gdn_prep_task(const Params& p, int pass, float* An, int tk, int lane) {
  const int r = lane & 31, h2 = lane >> 5;
  const int n = tk % 132, bh = tk / 132, hh = bh & 7, bl = bh >> 3;
  const size_t r0 = (size_t)bl * TOK + (size_t)n * 64;
  const u16* qb = WS_QKVB(p) + r0 * 3072 + hh * 128;
  const u16* kb = qb + 1024;
  const float g = WS_AB(p)[(r0 + lane) * 32 + DIR * 8 + hh], be = WS_AB(p)[(r0 + lane) * 32 + 16 + DIR * 8 + hh];
  bf16x8 kf[8][2], qf[8][2];
  {
    const u16* krow_ = kb + (size_t)r * 3072 + 8 * h2;
    const u16* qrow_ = qb + (size_t)r * 3072 + 8 * h2;
#pragma unroll
    for (int s = 0; s < 8; ++s)
#pragma unroll
      for (int rt = 0; rt < 2; ++rt) kf[s][rt] = *(const bf16x8*)(krow_ + (size_t)rt * 32 * 3072 + 16 * s);
#pragma unroll
    for (int s = 0; s < 8; ++s)
#pragma unroll
      for (int rt = 0; rt < 2; ++rt) qf[s][rt] = *(const bf16x8*)(qrow_ + (size_t)rt * 32 * 3072 + 16 * s);
  }
  An[lane] = g;
  asm volatile("" ::: "memory");
  float b = 0.f, blast = 0.f;
#pragma unroll
  for (int j4 = 0; j4 < 16; ++j4) {
    const float4 gv = *(const float4*)(An + 4 * j4);
    blast += (gv.x + gv.y) + (gv.z + gv.w);
    const int j = 4 * j4;
    if (DIR == 0) { b += (j <= lane ? gv.x : 0.f) + (j + 1 <= lane ? gv.y : 0.f) + (j + 2 <= lane ? gv.z : 0.f) + (j + 3 <= lane ? gv.w : 0.f); }
    else { b += (j >= lane ? gv.x : 0.f) + (j + 1 >= lane ? gv.y : 0.f) + (j + 2 >= lane ? gv.z : 0.f) + (j + 3 >= lane ? gv.w : 0.f); }
  }
  asm volatile("" ::: "memory");
  float* gs = WS_GS(p) + (size_t)(tk * 2 + DIR) * 256;
  gs[lane] = __expf(b); gs[64 + lane] = __expf(blast - b); gs[128 + lane] = be; if (lane == 0) gs[192] = __expf(blast);
  u16* pout = (DIR ? (u16*)(p.out + (size_t)pass * MPL * 1024) : WS_PPf(p)) + (size_t)tk * 4096;
#pragma unroll
  for (int i = 0; i < 16; ++i) *(float4*)(An + (i * 64 + lane) * 4) = make_float4(0.f, 0.f, 0.f, 0.f);
  asm volatile("" ::: "memory");
  An[lane] = b;
  asm volatile("" ::: "memory");
  const float bs0 = An[r], bs1 = An[32 + r];
  asm volatile("" ::: "memory");
#pragma unroll
  for (int which = 0; which < 2; ++which) {
    f32x16 kk[2][2];
#pragma unroll
    for (int a = 0; a < 2; ++a)
#pragma unroll
      for (int c = 0; c < 2; ++c)
#pragma unroll
        for (int i = 0; i < 16; ++i) kk[a][c][i] = 0.f;
    asm volatile("" ::: "memory");
    An[lane] = which ? b : b + __logf(be);
    asm volatile("" ::: "memory");
#pragma unroll
    for (int s = 0; s < 8; ++s)
#pragma unroll
      for (int rt = 0; rt < 2; ++rt)
#pragma unroll
        for (int ct = 0; ct < 2; ++ct) kk[rt][ct] = MFMA32(which ? qf[s][rt] : kf[s][rt], kf[s][ct], kk[rt][ct]);
    const int lpart = 4 * h2 * 64 + r;
    u16* pb = pout + lpart;
    float* ab0 = DIR ? (An + 4095 - lpart) : (An + lpart);
    const float* brow = An + 4 * h2;
    int r_o = r, h4_o = 4 * h2;
    asm volatile("" : "+v"(pb), "+v"(ab0), "+v"(brow), "+v"(r_o), "+v"(h4_o));
#pragma unroll
    for (int rt = 0; rt < 2; ++rt)
#pragma unroll
      for (int i = 0; i < 16; ++i) {
        const int tc = rt * 32 + (i & 3) + 8 * (i >> 2);
        const int t = tc + h4_o;
        const float bt = brow[tc];
#pragma unroll
        for (int ct = 0; ct < 2; ++ct) {
          const int sidx = ct * 32 + r_o;
          const bool strict = DIR ? (sidx > t) : (sidx < t);
          const bool incl = strict || (sidx == t);
          const float dec = incl ? __expf(bt - (ct ? bs1 : bs0)) : 0.f;
          if (which == 0) { if (strict) { if (DIR) ab0[-(tc * 64 + ct * 32)] = kk[rt][ct][i] * dec; else ab0[tc * 64 + ct * 32] = kk[rt][ct][i] * dec; } }
          else pb[tc * 64 + ct * 32] = (u16)f2bf(kk[rt][ct][i] * dec);
        }
      }
    asm volatile("" ::: "memory");
  }
  float x[64];
#pragma unroll
  for (int i = 0; i < 64; ++i) x[i] = 0.f;
  int lane_s = lane;
  float4 ra[2][16];
#pragma unroll
  for (int i = 0; i < 64; ++i) {
    if (i + 1 < 64) {
#pragma unroll
      for (int j4 = 0; j4 < (i + 1 + 3) / 4; ++j4) ra[(i + 1) & 1][j4] = *(const float4*)(An + (i + 1) * 64 + 4 * j4);
    }
    __builtin_amdgcn_sched_barrier(0);
    asm volatile("" : "+v"(lane_s));
    float acc = (i == lane_s) ? 1.f : 0.f;
#pragma unroll
    for (int j4 = 0; j4 < (i + 3) / 4; ++j4) {
      const float4 a = ra[i & 1][j4];
      acc -= a.x * x[4 * j4 + 0]; acc -= a.y * x[4 * j4 + 1]; acc -= a.z * x[4 * j4 + 2]; acc -= a.w * x[4 * j4 + 3];
    }
    asm volatile("" : "+v"(acc));
    x[i] = acc;
    __builtin_amdgcn_sched_barrier(0);
  }
  u16* tout = (DIR ? WS_TPb(p) : WS_TPf(p)) + (size_t)tk * 4096;
  u16* tcol = tout + (DIR ? (63 * 64 + 63 - lane_s) : lane_s);
  asm volatile("" : "+v"(tcol));
#pragma unroll
  for (int i = 0; i < 64; ++i) { if (DIR) tcol[-(i * 64)] = (u16)f2bf(x[i]); else tcol[i * 64] = (u16)f2bf(x[i]); }
  asm volatile("" ::: "memory");
}

__device__ void gdn_prep(const Params& p, int pass, unsigned char* smem) {
  const int tid = tid_opaque(), wv = tid >> 6;
  float* An = (float*)smem + wv * 4096;
  const int gw = bid_opaque() * 8 + wv, nw = gridDim.x * 8;
#ifdef PROBE_GPREP2
  for (int rep = 0; rep < 2; ++rep)
#endif
  for (int wt = gw; wt < 2112 * 2; wt += nw) {
    int lane = tid & 63; asm volatile("" : "+v"(lane));
    if (wt & 1) gdn_prep_task<1>(p, pass, An, wt >> 1, lane); else gdn_prep_task<0>(p, pass, An, wt >> 1, lane);
  }
}

#define SEQ_BAR() do { asm volatile("s_waitcnt lgkmcnt(0)" ::: "memory"); __builtin_amdgcn_s_barrier(); asm volatile("" ::: "memory"); } while (0)
__device__ __forceinline__ int gdn_chunk_of(int dir, int i) { return dir == 0 ? i : (i < 4 ? 3 - i : 135 - i); }

__device__ void gdn_seq(const Params& p, int pass, int chain, int vh, unsigned char* smem, int dry) {
  const int tid = tid_opaque(), lane = tid & 63, wv = tid >> 6, r = lane & 31, h2 = lane >> 5;
  const int dir = chain & 1, hh = (chain >> 1) & 7, bl = chain >> 4;
  constexpr int RS = 136, RT = 72;
  constexpr int BUF = 3 * 64 * RS + 2 * 64 * RT + 512;
  const u16* PPb = (const u16*)(p.out + (size_t)pass * MPL * 1024);
  const u16* Tg = dir ? WS_TPb(p) : WS_TPf(p); const u16* Pg = dir ? PPb : WS_PPf(p);
  u16* O = (u16*)WS_H(p) + (size_t)(2 + dir) * MPL * 1024;
  const int v0 = vh * 32;
  const bool isO = wv == 1;
  u32x4* XV = (u32x4*)((u16*)smem + 2 * BUF) + lane;
  const int tq = (lane & 15) >> 2, tp = lane & 3, blk = (lane >> 4) & 1;
  const int zro = dir ? 1 : 0, zrt = dir ? 0 : 1;
  if (wv >= 4) {
    const int lt = tid - 256;
    u32x4 preA[13], preB[13]; float pregA = 0.f, pregB = 0.f;
    auto issue = [&](int n, u32x4 (&pre)[13], float& preg) {
      const int tk = (bl * 8 + hh) * 132 + n;
      const size_t r0 = (size_t)bl * TOK + (size_t)n * 64;
      const u16* base = WS_QKVB(p) + r0 * 3072 + hh * 128;
#pragma unroll
      for (int j = 0; j < 8; ++j) { const int piece = lt + 256 * (j & 3), row = piece >> 4, ch = piece & 15; pre[j] = *(const u32x4*)(base + (size_t)row * 3072 + (j >> 2) * 1024 + ch * 8); }
      pre[8] = *(const u32x4*)(base + (size_t)(lt >> 2) * 3072 + 2048 + (vh * 4 + (lt & 3)) * 8);
#pragma unroll
      for (int j = 0; j < 2; ++j) { pre[9 + j] = *(const u32x4*)(Tg + (size_t)tk * 4096 + (lt + 256 * j) * 8); pre[11 + j] = *(const u32x4*)(Pg + (size_t)tk * 4096 + (lt + 256 * j) * 8); }
      if (lt < 193) preg = WS_GS(p)[(size_t)(tk * 2 + dir) * 256 + lt];
    };
    auto stage = [&](int b, const u32x4 (&pre)[13], float preg) {
      u16* sQ = (u16*)smem + b * BUF; u16* sT = sQ + 3 * 64 * RS; u16* sP = sT + 64 * RT; float* sG = (float*)(sP + 64 * RT);
#pragma unroll
      for (int j = 0; j < 8; ++j) { const int piece = lt + 256 * (j & 3), row = piece >> 4, ch = piece & 15; *(u32x4*)(sQ + (j >> 2) * 64 * RS + row * RS + ch * 8) = pre[j]; }
      *(u32x4*)(sQ + 2 * 64 * RS + (lt >> 2) * RS + (vh * 4 + (lt & 3)) * 8) = pre[8];
#pragma unroll
      for (int j = 0; j < 2; ++j) { const int piece = lt + 256 * j, row = piece >> 3, ch = piece & 7; *(u32x4*)(sT + row * RT + ch * 8) = pre[9 + j]; *(u32x4*)(sP + row * RT + ch * 8) = pre[11 + j]; }
      if (lt < 193) sG[lt] = preg;
    };
    const u16* OTl = (const u16*)smem + 2 * BUF + 2048;
    auto flushO = [&](int itp) {
      const int np = gdn_chunk_of(dir, itp);
      if (np >= 4 && !dry) {
        const int row = lt >> 2, pc = lt & 3;
        const u32x4 v = *(const u32x4*)(OTl + (itp & 1) * 2560 + row * 40 + pc * 8);
        *(u32x4*)(O + ((size_t)bl * SEQ + (size_t)(np - 4) * 64 + row) * 1024 + hh * 128 + vh * 32 + pc * 8) = v;
      }
    };
    issue(gdn_chunk_of(dir, 0), preA, pregA);
    stage(0, preA, pregA);
    issue(gdn_chunk_of(dir, 1), preA, pregA);
    issue(gdn_chunk_of(dir, 2), preB, pregB);
    SEQ_BAR();
    for (int it = 0; it < 132; it += 2) {
      if (it > 0) flushO(it - 1);
      stage((it + 1) & 1, preA, pregA);
      if (it + 3 < 132) issue(gdn_chunk_of(dir, it + 3), preA, pregA);
      SEQ_BAR();
      SEQ_BAR();
      flushO(it);
      if (it + 2 < 132) stage((it + 2) & 1, preB, pregB);
      if (it + 4 < 132) issue(gdn_chunk_of(dir, it + 4), preB, pregB);
      SEQ_BAR();
      SEQ_BAR();
    }
    flushO(131);
    return;
  }
  if (wv >= 2) { SEQ_BAR(); for (int it = 0; it < 132; ++it) { SEQ_BAR(); SEQ_BAR(); } return; }
  f32x16 S[4];
#pragma unroll
  for (int kt = 0; kt < 4; ++kt)
#pragma unroll
    for (int i = 0; i < 16; ++i) S[kt][i] = 0.f;
  SEQ_BAR();
#define SB_() __builtin_amdgcn_sched_barrier(0)
  if (!isO) {
  for (int it = 0; it < 132; ++it) {
    const int n = gdn_chunk_of(dir, it);
    const u16* sQ = (const u16*)smem + (it & 1) * BUF; const u16* sK = sQ + 64 * RS; const u16* sV = sK + 64 * RS; const u16* sT = sV + 64 * RS; const u16* sP = sT + 64 * RT;
    const float* sG = (const float*)(sP + 64 * RT);
    const int offA = r * RS;
    bf16x8 Vbs[2][2];
      f32x16 X[2];
#pragma unroll
      for (int rt = 0; rt < 2; ++rt)
#pragma unroll
        for (int i = 0; i < 16; ++i) X[rt][i] = 0.f;
      bf16x8 fk[2][4];
#define LDG_(kt, b) do { _Pragma("unroll") for (int rt = 0; rt < 2; ++rt) _Pragma("unroll") for (int s2 = 0; s2 < 2; ++s2) \
        fk[b][rt * 2 + s2] = ld_perm(sK + offA + 32 * rt * RS + 32 * (kt) + 16 * s2, h2); } while (0)
      LDG_(0, 0);
#pragma unroll
      for (int kt = 0; kt < 4; ++kt) {
        SB_();
        if (kt < 3) LDG_(kt + 1, (kt + 1) & 1);
        const bf16x8 sb0 = pack8(S[kt], 0), sb1 = pack8(S[kt], 1);
        SB_();
        X[0] = MFMA32(fk[kt & 1][0], sb0, X[0]); X[1] = MFMA32(fk[kt & 1][2], sb0, X[1]);
        X[0] = MFMA32(fk[kt & 1][1], sb1, X[0]); X[1] = MFMA32(fk[kt & 1][3], sb1, X[1]);
      }
#undef LDG_
      SB_();
      bf16x8 ft[3][2];
#pragma unroll
      for (int s2 = 0; s2 < 2; ++s2) {
        ft[0][s2] = ld_perm(sT + (r) * RT + 16 * s2, h2);
        ft[1][s2] = ld_perm(sT + (32 + r) * RT + 32 + 16 * s2, h2);
        ft[2][s2] = ld_perm(sT + (32 * zrt + r) * RT + 32 * zro + 16 * s2, h2);
      }
#pragma unroll
      for (int rt = 0; rt < 2; ++rt) {
        float vv[16]; float4 eb4[4], be4[4];
        const int tb = 32 * rt + 4 * h2;
#pragma unroll
        for (int g = 0; g < 4; ++g) { eb4[g] = *(const float4*)(sG + tb + 8 * g); be4[g] = *(const float4*)(sG + 128 + tb + 8 * g); }
#pragma unroll
        for (int i = 0; i < 16; ++i) vv[i] = bf2f(sV[(tb + (i & 3) + 8 * (i >> 2)) * RS + v0 + r]);
        SB_();
#pragma unroll
        for (int g = 0; g < 4; ++g) {
          X[rt][4 * g + 0] = be4[g].x * (vv[4 * g + 0] - eb4[g].x * X[rt][4 * g + 0]);
          X[rt][4 * g + 1] = be4[g].y * (vv[4 * g + 1] - eb4[g].y * X[rt][4 * g + 1]);
          X[rt][4 * g + 2] = be4[g].z * (vv[4 * g + 2] - eb4[g].z * X[rt][4 * g + 2]);
          X[rt][4 * g + 3] = be4[g].w * (vv[4 * g + 3] - eb4[g].w * X[rt][4 * g + 3]);
        }
        SB_();
      }
      bf16x8 Yb[2][2];
#pragma unroll
      for (int rt = 0; rt < 2; ++rt) { Yb[rt][0] = pack8(X[rt], 0); Yb[rt][1] = pack8(X[rt], 1); }
      f32x16 VN[2];
#pragma unroll
      for (int ro = 0; ro < 2; ++ro)
#pragma unroll
        for (int i = 0; i < 16; ++i) VN[ro][i] = 0.f;
      VN[0] = MFMA32(ft[0][0], Yb[0][0], VN[0]); VN[1] = MFMA32(ft[1][0], Yb[1][0], VN[1]);
      VN[0] = MFMA32(ft[0][1], Yb[0][1], VN[0]); VN[1] = MFMA32(ft[1][1], Yb[1][1], VN[1]);
      if (dir == 0) { VN[1] = MFMA32(ft[2][0], Yb[0][0], VN[1]); VN[1] = MFMA32(ft[2][1], Yb[0][1], VN[1]); }
      else { VN[0] = MFMA32(ft[2][0], Yb[1][0], VN[0]); VN[0] = MFMA32(ft[2][1], Yb[1][1], VN[0]); }
#pragma unroll
      for (int rt = 0; rt < 2; ++rt)
#pragma unroll
        for (int s2 = 0; s2 < 2; ++s2) XV[(rt * 2 + s2) * 64] = __builtin_bit_cast(u32x4, pack8(VN[rt], s2));
      SEQ_BAR();
#pragma unroll
      for (int rt = 0; rt < 2; ++rt)
#pragma unroll
        for (int g = 0; g < 4; ++g) {
          const float4 el4 = *(const float4*)(sG + 64 + 32 * rt + 8 * g + 4 * h2);
          VN[rt][4 * g + 0] *= el4.x; VN[rt][4 * g + 1] *= el4.y; VN[rt][4 * g + 2] *= el4.z; VN[rt][4 * g + 3] *= el4.w;
        }
#pragma unroll
      for (int rt = 0; rt < 2; ++rt) { Vbs[rt][0] = pack8(VN[rt], 0); Vbs[rt][1] = pack8(VN[rt], 1); }
    {
      const float el = sG[192];
      bf16x8 fa[2][4];
#define LDT_(kt, b) do { _Pragma("unroll") for (int rt = 0; rt < 2; ++rt) _Pragma("unroll") for (int s2 = 0; s2 < 2; ++s2) { \
        const u16* a0 = sK + (32 * rt + 16 * s2 + 4 * h2 + tq) * RS + 32 * (kt) + 16 * blk + 4 * tp; fa[b][rt * 2 + s2] = cat4(tr_rd(a0), tr_rd(a0 + 8 * RS)); } } while (0)
      LDT_(0, 0);
#pragma unroll
      for (int kt = 0; kt < 4; ++kt) {
        SB_();
        if (kt < 3) LDT_(kt + 1, (kt + 1) & 1);
#pragma unroll
        for (int i = 0; i < 16; ++i) S[kt][i] *= el;
        SB_();
        S[kt] = MFMA32(fa[kt & 1][0], Vbs[0][0], S[kt]); S[kt] = MFMA32(fa[kt & 1][1], Vbs[0][1], S[kt]);
        S[kt] = MFMA32(fa[kt & 1][2], Vbs[1][0], S[kt]); S[kt] = MFMA32(fa[kt & 1][3], Vbs[1][1], S[kt]);
      }
#undef LDT_
    }
    SEQ_BAR();
  }
  } else {
  for (int it = 0; it < 132; ++it) {
    const int n = gdn_chunk_of(dir, it);
    const u16* sQ = (const u16*)smem + (it & 1) * BUF; const u16* sK = sQ + 64 * RS; const u16* sV = sK + 64 * RS; const u16* sT = sV + 64 * RS; const u16* sP = sT + 64 * RT;
    const float* sG = (const float*)(sP + 64 * RT);
    const int offA = r * RS;
    bf16x8 Vbs[2][2];
      f32x16 QS[2];
#pragma unroll
      for (int rt = 0; rt < 2; ++rt)
#pragma unroll
        for (int i = 0; i < 16; ++i) QS[rt][i] = 0.f;
      bf16x8 fq[2][4];
#define LDG_(kt, b) do { _Pragma("unroll") for (int rt = 0; rt < 2; ++rt) _Pragma("unroll") for (int s2 = 0; s2 < 2; ++s2) \
        fq[b][rt * 2 + s2] = ld_perm(sQ + offA + 32 * rt * RS + 32 * (kt) + 16 * s2, h2); } while (0)
      LDG_(0, 0);
#pragma unroll
      for (int kt = 0; kt < 4; ++kt) {
        SB_();
        if (kt < 3) LDG_(kt + 1, (kt + 1) & 1);
        const bf16x8 sb0 = pack8(S[kt], 0), sb1 = pack8(S[kt], 1);
        SB_();
        QS[0] = MFMA32(fq[kt & 1][0], sb0, QS[0]); QS[1] = MFMA32(fq[kt & 1][2], sb0, QS[1]);
        QS[0] = MFMA32(fq[kt & 1][1], sb1, QS[0]); QS[1] = MFMA32(fq[kt & 1][3], sb1, QS[1]);
      }
#undef LDG_
      SB_();
      bf16x8 fp[3][2];
#pragma unroll
      for (int s2 = 0; s2 < 2; ++s2) {
        fp[0][s2] = ld_perm(sP + (r) * RT + 16 * s2, h2);
        fp[1][s2] = ld_perm(sP + (32 + r) * RT + 32 + 16 * s2, h2);
        fp[2][s2] = ld_perm(sP + (32 * zrt + r) * RT + 32 * zro + 16 * s2, h2);
      }
#pragma unroll
      for (int rt = 0; rt < 2; ++rt)
#pragma unroll
        for (int g = 0; g < 4; ++g) {
          const float4 eb4 = *(const float4*)(sG + 32 * rt + 8 * g + 4 * h2);
          QS[rt][4 * g + 0] *= eb4.x; QS[rt][4 * g + 1] *= eb4.y; QS[rt][4 * g + 2] *= eb4.z; QS[rt][4 * g + 3] *= eb4.w;
        }
      SEQ_BAR();
      u32x4 vraw[2][2];
#pragma unroll
      for (int rt = 0; rt < 2; ++rt)
#pragma unroll
        for (int s2 = 0; s2 < 2; ++s2) vraw[rt][s2] = XV[(rt * 2 + s2) * 64];
      QS[0] = MFMA32(fp[0][0], __builtin_bit_cast(bf16x8, vraw[0][0]), QS[0]); QS[1] = MFMA32(fp[1][0], __builtin_bit_cast(bf16x8, vraw[1][0]), QS[1]);
      QS[0] = MFMA32(fp[0][1], __builtin_bit_cast(bf16x8, vraw[0][1]), QS[0]); QS[1] = MFMA32(fp[1][1], __builtin_bit_cast(bf16x8, vraw[1][1]), QS[1]);
      if (dir == 0) { QS[1] = MFMA32(fp[2][0], __builtin_bit_cast(bf16x8, vraw[0][0]), QS[1]); QS[1] = MFMA32(fp[2][1], __builtin_bit_cast(bf16x8, vraw[0][1]), QS[1]); }
      else { QS[0] = MFMA32(fp[2][0], __builtin_bit_cast(bf16x8, vraw[1][0]), QS[0]); QS[0] = MFMA32(fp[2][1], __builtin_bit_cast(bf16x8, vraw[1][1]), QS[0]); }
#pragma unroll
      for (int rt = 0; rt < 2; ++rt)
#pragma unroll
        for (int s2 = 0; s2 < 2; ++s2) {
          const int t0 = 32 * rt + 16 * s2 + 4 * h2;
          const float4 ea = *(const float4*)(sG + 64 + t0), ec = *(const float4*)(sG + 64 + t0 + 8);
          const u32x4 w = vraw[rt][s2];
          u32x4 o4;
          o4.x = pk2bf(bf2f(w.x & 0xFFFFu) * ea.x, bf2f(w.x >> 16) * ea.y); o4.y = pk2bf(bf2f(w.y & 0xFFFFu) * ea.z, bf2f(w.y >> 16) * ea.w);
          o4.z = pk2bf(bf2f(w.z & 0xFFFFu) * ec.x, bf2f(w.z >> 16) * ec.y); o4.w = pk2bf(bf2f(w.w & 0xFFFFu) * ec.z, bf2f(w.w >> 16) * ec.w);
          Vbs[rt][s2] = __builtin_bit_cast(bf16x8, o4);
        }
      if (n >= 4 && !dry) {
        u16* ot = (u16*)smem + 2 * BUF + 2048 + (it & 1) * 2560 + 4 * h2 * 40 + r;
#pragma unroll
        for (int rt = 0; rt < 2; ++rt)
#pragma unroll
          for (int i = 0; i < 16; ++i) ot[(32 * rt + (i & 3) + 8 * (i >> 2)) * 40] = (u16)f2bf(QS[rt][i]);
      }

    {
      const float el = sG[192];
      bf16x8 fa[2][4];
#define LDT_(kt, b) do { _Pragma("unroll") for (int rt = 0; rt < 2; ++rt) _Pragma("unroll") for (int s2 = 0; s2 < 2; ++s2) { \
        const u16* a0 = sK + (32 * rt + 16 * s2 + 4 * h2 + tq) * RS + 32 * (kt) + 16 * blk + 4 * tp; fa[b][rt * 2 + s2] = cat4(tr_rd(a0), tr_rd(a0 + 8 * RS)); } } while (0)
      LDT_(0, 0);
#pragma unroll
      for (int kt = 0; kt < 4; ++kt) {
        SB_();
        if (kt < 3) LDT_(kt + 1, (kt + 1) & 1);
#pragma unroll
        for (int i = 0; i < 16; ++i) S[kt][i] *= el;
        SB_();
        S[kt] = MFMA32(fa[kt & 1][0], Vbs[0][0], S[kt]); S[kt] = MFMA32(fa[kt & 1][1], Vbs[0][1], S[kt]);
        S[kt] = MFMA32(fa[kt & 1][2], Vbs[1][0], S[kt]); S[kt] = MFMA32(fa[kt & 1][3], Vbs[1][1], S[kt]);
      }
#undef LDT_
    }
    SEQ_BAR();
  }
  }
#undef SB_
}

__device__ void hgrn_prep(const Params& p, int pass, unsigned char* smem, int dry) {
  const int tid = tid_opaque(), lane = tid & 63, wv = tid >> 6;
  constexpr int RSA = 136, RSS = 72;
  u16* sQs = (u16*)smem; u16* sQd = sQs + 64 * RSA; u16* sKs = sQd + 64 * RSA; u16* sKv = sKs + 64 * RSA;
  u16* sV = sKv + 48 * RSA; u16* sS = sV + 64 * RSA;
  float* sDG = (float*)(sS + 64 * RSS);
  u16* sQr = (u16*)(sDG + 512);
  u16* sGr = sQr + 64 * RSA;
  u16* QDB = (u16*)(p.out + (size_t)pass * MPL * 1024) + (size_t)2112 * 4096;
  u16* Of = (u16*)WS_H(p);
  const int k = tid & 127, I = tid >> 7;
  const int prow0 = tid >> 4, pch = tid & 15;
  u32x4 pf[6];
  auto issue_task = [&](int tkx, u32x4 (&d)[6]) {
    const int nx_ = tkx % 132, bhx = tkx / 132;
    const u16* yx = WS_YA(p) + ((size_t)(bhx >> 3) * TOK + (size_t)nx_ * 64) * 4096 + (bhx & 7) * 128;
#pragma unroll
    for (int hf = 0; hf < 2; ++hf) {
      const u16* rp = yx + (size_t)(prow0 + 32 * hf) * 4096 + pch * 8;
      d[hf] = *(const u32x4*)(rp + 3072); d[2 + hf] = *(const u32x4*)(rp); d[4 + hf] = *(const u32x4*)(rp + 1024);
    }
  };
  int tk = (int)gridDim.x - 1 - bid_opaque();
  if (tk < 2112) issue_task(tk, pf);
  for (; tk < 2112; tk += gridDim.x) {
    const int n = tk % 132, bh = tk / 132, hh = bh & 7, bl = bh >> 3;
    const size_t r0 = (size_t)bl * TOK + (size_t)n * 64;
    u16* ya = WS_YA(p) + r0 * 4096 + hh * 128;
    __syncthreads();
    *(u32x4*)(sV + prow0 * RSA + pch * 8) = pf[0]; *(u32x4*)(sV + (prow0 + 32) * RSA + pch * 8) = pf[1];
    *(u32x4*)(sQr + prow0 * RSA + pch * 8) = pf[2]; *(u32x4*)(sQr + (prow0 + 32) * RSA + pch * 8) = pf[3];
    __syncthreads();
    const u32x4 gB0 = *(const u32x4*)(ya + (size_t)prow0 * 4096 + 2048 + pch * 8), gB1 = *(const u32x4*)(ya + (size_t)(prow0 + 32) * 4096 + 2048 + pch * 8);
    u32x4 nx[6];
    if (tk + (int)gridDim.x < 2112) issue_task(tk + gridDim.x, nx);
    float qv[16];
#pragma unroll
    for (int j = 0; j < 16; ++j) qv[j] = bf2f(sQr[(16 * I + j) * RSA + k]);
#pragma unroll 1
    for (int dir = 0; dir < 2; ++dir) {
      const int P = dir ? 3 - I : I;
      u16* gt = ya + 1024 + dir * 1024;
      {
        const u32x4 g0 = dir ? gB0 : pf[4], g1 = dir ? gB1 : pf[5];
        __syncthreads();
        *(u32x4*)(sGr + prow0 * RSA + pch * 8) = g0; *(u32x4*)(sGr + (prow0 + 32) * RSA + pch * 8) = g1;
      }
      __syncthreads();
      float c[16];
#pragma unroll
      for (int j = 0; j < 16; ++j) c[j] = h2f(sGr[(16 * I + j) * RSA + k]);
      float kkv[16];
#pragma unroll
      for (int j = 0; j < 16; ++j) kkv[j] = 1.f - __expf(c[j]);
      if (dir == 0) {
#pragma unroll
        for (int j = 1; j < 16; ++j) c[j] += c[j - 1];
      } else {
#pragma unroll
        for (int j = 14; j >= 0; --j) c[j] += c[j + 1];
      }
      const float G = dir ? c[0] : c[15];
      const float DG = __expf(G), rDG = 1.f / DG;
      float Qs[16], Ks[16];
#pragma unroll
      for (int j = 0; j < 16; ++j) {
        Qs[j] = qv[j] * __expf(c[j]);
        Ks[j] = kkv[j] * __expf(G - c[j]);
        const int o = (16 * I + j) * RSA + k;
        sQs[o] = (u16)f2bf(Qs[j]); sQd[o] = (u16)f2bf(Qs[j] * rDG); sKs[o] = (u16)f2bf(Ks[j]);
      }
      sDG[P * 128 + k] = DG;
      __syncthreads();
      const float d0 = sDG[k], d1 = sDG[128 + k], d2 = sDG[256 + k], d3 = sDG[384 + k];
      const float Pfac = P == 0 ? 1.f : (P == 1 ? d0 : (P == 2 ? d0 * d1 : d0 * d1 * d2));
      const float Rfac = P == 3 ? 1.f : (P == 2 ? d3 : (P == 1 ? d2 * d3 : d1 * d2 * d3));
#pragma unroll
      for (int j = 0; j < 16; ++j) { const int o = (16 * I + j) * RSA + k; sQr[o] = (u16)f2bf(Qs[j] * Pfac); sGr[o] = (u16)f2bf(Ks[j] * Rfac); }
      if (I == 0 && !dry) WS_DL(p)[(size_t)(tk * 2 + dir) * 128 + k] = (d0 * d1) * (d2 * d3);
      if (P == 0) {
#pragma unroll
        for (int j = 0; j < 16; ++j) { sKv[j * RSA + k] = (u16)f2bf(Ks[j] * d1); sKv[(32 + j) * RSA + k] = (u16)f2bf(Ks[j] * d1 * d2); }
      } else if (P == 1) {
#pragma unroll
        for (int j = 0; j < 16; ++j) sKv[(16 + j) * RSA + k] = (u16)f2bf(Ks[j] * d2);
      }
      __syncthreads();
      if (!dry) {
        const u32x4 a0 = *(const u32x4*)(sQr + prow0 * RSA + pch * 8), a1 = *(const u32x4*)(sQr + (prow0 + 32) * RSA + pch * 8);
        const u32x4 b0 = *(const u32x4*)(sGr + prow0 * RSA + pch * 8), b1 = *(const u32x4*)(sGr + (prow0 + 32) * RSA + pch * 8);
        if (dir) { u16* qd = QDB + (size_t)tk * 8192; *(u32x4*)(qd + prow0 * 128 + pch * 8) = a0; *(u32x4*)(qd + (prow0 + 32) * 128 + pch * 8) = a1; }
        else { *(u32x4*)(ya + (size_t)prow0 * 4096 + pch * 8) = a0; *(u32x4*)(ya + (size_t)(prow0 + 32) * 4096 + pch * 8) = a1; }
        *(u32x4*)(gt + (size_t)prow0 * 4096 + pch * 8) = b0; *(u32x4*)(gt + (size_t)(prow0 + 32) * 4096 + pch * 8) = b1;
      }
      if (n >= 4) {
        const int fr = lane & 15, quad = lane >> 4;
#pragma unroll 1
        for (int blk = wv; blk < 10; blk += 8) {
          int Pt, Ps; const u16* bsrc;
          if (blk < 4) { Pt = blk; Ps = blk; }
          else if (blk < 7) { Pt = blk - 3; Ps = blk - 4; }
          else if (blk == 7) { Pt = 2; Ps = 0; }
          else if (blk == 8) { Pt = 3; Ps = 1; }
          else { Pt = 3; Ps = 0; }
          const int It = dir ? 3 - Pt : Pt, Is = dir ? 3 - Ps : Ps;
          if (blk < 7) bsrc = sKs + (16 * Is + fr) * RSA; else bsrc = sKv + (16 * (blk - 7) + fr) * RSA;
          const u16* asrc = (blk < 4 ? sQd : sQs) + (16 * It + fr) * RSA;
          f32x4 acc = {0.f, 0.f, 0.f, 0.f};
#pragma unroll
          for (int kq = 0; kq < 4; ++kq) acc = __builtin_amdgcn_mfma_f32_16x16x32_bf16(*(const bf16x8*)(asrc + 32 * kq + 8 * quad), *(const bf16x8*)(bsrc + 32 * kq + 8 * quad), acc, 0, 0, 0);
#pragma unroll
          for (int j = 0; j < 4; ++j) {
            const int tl = 4 * quad + j;
            float val = acc[j];
            u16* dst = sS + (16 * It + tl) * RSS + 16 * Is + fr;
            if (blk < 4) {
              const bool keep = dir ? (fr >= tl) : (fr <= tl);
              val = keep ? val : 0.f;
              if (dir) val += bf2f(*dst);
            }
            *dst = (u16)f2bf(val);
          }
        }
      }
      __syncthreads();
    }
    if (n >= 4) {
      const int r = lane & 31, h2 = lane >> 5, rt = wv >> 2, ct = wv & 3;
      const int tq = (lane & 15) >> 2, tp = lane & 3, blk = (lane >> 4) & 1;
      f32x16 acc;
#pragma unroll
      for (int i = 0; i < 16; ++i) acc[i] = 0.f;
#pragma unroll
      for (int s = 0; s < 4; ++s) {
        const bf16x8 a = *(const bf16x8*)(sS + (32 * rt + r) * RSS + 16 * s + 8 * h2);
        const u16* b0 = sV + (16 * s + 8 * h2 + tq) * RSA + 32 * ct + 16 * blk + 4 * tp;
        acc = MFMA32(a, cat4(tr_rd(b0), tr_rd(b0 + 4 * RSA)), acc);
      }
      u16* op = Of + ((size_t)bl * SEQ + (size_t)(n - 4) * 64 + 4 * h2) * 1024 + hh * 128 + 32 * ct + r;
      if (!dry) {
#pragma unroll
        for (int i = 0; i < 16; ++i) op[(size_t)(32 * rt + (i & 3) + 8 * (i >> 2)) * 1024] = (u16)f2bf(acc[i]);
      }
    }
#pragma unroll
    for (int j = 0; j < 6; ++j) pf[j] = nx[j];
  }
  __syncthreads();
}

__device__ void hgrn_seq(const Params& p, int pass, int chain, int vh, unsigned char* smem, int dry) {
  const int tid = tid_opaque(), lane = tid & 63, wv = tid >> 6, r = lane & 31, h2 = lane >> 5;
  const int dir = chain & 1, hh = (chain >> 1) & 7, bl = chain >> 4;
  constexpr int RS = 136;
  constexpr int BUF = 4 * 64 * RS + 256;
  const u16* QDB = (const u16*)(p.out + (size_t)pass * MPL * 1024) + (size_t)2112 * 4096;
  u16* O = (u16*)WS_H(p) + (size_t)dir * MPL * 1024;
  if (wv >= 4) {
    const int lt = tid - 256;
    u32x4 preA[10], preB[10]; float pregA = 0.f, pregB = 0.f;
    auto issue = [&](int n, u32x4 (&pre)[10], float& preg) {
      const int tk = (bl * 8 + hh) * 132 + n;
      const size_t r0 = (size_t)bl * TOK + (size_t)n * 64;
      const u16* ya = WS_YA(p) + r0 * 4096 + hh * 128;
#pragma unroll
      for (int j = 0; j < 4; ++j) {
        const int piece = lt + 256 * j, row = piece >> 4, ch = piece & 15;
        pre[j] = dir ? *(const u32x4*)(QDB + (size_t)tk * 8192 + row * 128 + ch * 8) : *(const u32x4*)(ya + (size_t)row * 4096 + ch * 8);
        pre[4 + j] = *(const u32x4*)(ya + (size_t)row * 4096 + 1024 + dir * 1024 + ch * 8);
      }
      {
        const int row = lt >> 2, ch = vh * 4 + (lt & 3);
        pre[8] = *(const u32x4*)(ya + (size_t)row * 4096 + 3072 + ch * 8);
        if (dir == 0 && n >= 4) pre[9] = *(const u32x4*)(O + ((size_t)bl * SEQ + (size_t)(n - 4) * 64 + row) * 1024 + hh * 128 + ch * 8);
      }
      if (lt < 128) preg = WS_DL(p)[(size_t)(tk * 2 + dir) * 128 + lt];
    };
    auto stage = [&](int b, const u32x4 (&pre)[10], float preg) {
      u16* sQ = (u16*)smem + b * BUF; float* sD = (float*)(sQ + 4 * 64 * RS);
#pragma unroll
      for (int j = 0; j < 4; ++j) {
        const int piece = lt + 256 * j, row = piece >> 4, ch = piece & 15;
        *(u32x4*)(sQ + row * RS + ch * 8) = pre[j]; *(u32x4*)(sQ + 64 * RS + row * RS + ch * 8) = pre[4 + j];
      }
      {
        const int row = lt >> 2, ch = vh * 4 + (lt & 3);
        *(u32x4*)(sQ + 2 * 64 * RS + row * RS + ch * 8) = pre[8];
        if (dir == 0) *(u32x4*)(sQ + 3 * 64 * RS + row * RS + ch * 8) = pre[9];
      }
      if (lt < 128) sD[lt] = preg;
    };
    const u16* OTl = (const u16*)smem + 2 * BUF;
    auto flushO = [&](int itp) {
      const int np = gdn_chunk_of(dir, itp);
      if (np >= 4 && !dry) {
        const int row = lt >> 2, pc = lt & 3;
        const u32x4 v = *(const u32x4*)(OTl + (itp & 1) * 2560 + row * 40 + pc * 8);
        *(u32x4*)(O + ((size_t)bl * SEQ + (size_t)(np - 4) * 64 + row) * 1024 + hh * 128 + vh * 32 + pc * 8) = v;
      }
    };
    issue(gdn_chunk_of(dir, 0), preA, pregA);
    stage(0, preA, pregA);
    issue(gdn_chunk_of(dir, 1), preA, pregA);
    issue(gdn_chunk_of(dir, 2), preB, pregB);
    SEQ_BAR();
    for (int it = 0; it < 132; it += 2) {
      if (it > 0) flushO(it - 1);
      stage((it + 1) & 1, preA, pregA);
      if (it + 3 < 132) issue(gdn_chunk_of(dir, it + 3), preA, pregA);
      SEQ_BAR();
      flushO(it);
      if (it + 2 < 132) stage((it + 2) & 1, preB, pregB);
      if (it + 4 < 132) issue(gdn_chunk_of(dir, it + 4), preB, pregB);
      SEQ_BAR();
    }
    flushO(131);
    return;
  }
  f32x16 S[4];
#pragma unroll
  for (int kt = 0; kt < 4; ++kt)
#pragma unroll
    for (int i = 0; i < 16; ++i) S[kt][i] = 0.f;
  if (wv >= 1) { SEQ_BAR(); for (int it = 0; it < 132; ++it) SEQ_BAR(); return; }
  const int v0 = vh * 32;
  const int tq = (lane & 15) >> 2, tp = lane & 3, blk = (lane >> 4) & 1;
  SEQ_BAR();
  for (int it = 0; it < 132; ++it) {
    const int n = gdn_chunk_of(dir, it);
    const u16* sQ = (const u16*)smem + (it & 1) * BUF; const u16* sK = sQ + 64 * RS; const u16* sV = sK + 64 * RS; const u16* sO = sV + 64 * RS;
    const float* sD = (const float*)(sO + 64 * RS);
#define SB_() __builtin_amdgcn_sched_barrier(0)
    bf16x8 vb[2][2];
#pragma unroll
    for (int rt = 0; rt < 2; ++rt)
#pragma unroll
      for (int s2 = 0; s2 < 2; ++s2) {
        const u16* b0 = sV + (32 * rt + 16 * s2 + 8 * h2 + tq) * RS + v0 + 16 * blk + 4 * tp;
        vb[rt][s2] = cat4(tr_rd(b0), tr_rd(b0 + 4 * RS));
      }
    if (n >= 4 && !dry) {
      f32x16 X[2];
#pragma unroll
      for (int rt = 0; rt < 2; ++rt)
#pragma unroll
        for (int i = 0; i < 16; ++i) X[rt][i] = 0.f;
      bf16x8 fq[2][4];
      const int offA = r * RS;
#define LDG_(kt, b) do { _Pragma("unroll") for (int rt = 0; rt < 2; ++rt) _Pragma("unroll") for (int s2 = 0; s2 < 2; ++s2) \
        fq[b][rt * 2 + s2] = ld_perm(sQ + offA + 32 * rt * RS + 32 * (kt) + 16 * s2, h2); } while (0)
      LDG_(0, 0);
#pragma unroll
      for (int kt = 0; kt < 4; ++kt) {
        SB_();
        if (kt < 3) LDG_(kt + 1, (kt + 1) & 1);
        const bf16x8 sb0 = pack8(S[kt], 0), sb1 = pack8(S[kt], 1);
        SB_();
        X[0] = MFMA32(fq[kt & 1][0], sb0, X[0]); X[1] = MFMA32(fq[kt & 1][2], sb0, X[1]);
        X[0] = MFMA32(fq[kt & 1][1], sb1, X[0]); X[1] = MFMA32(fq[kt & 1][3], sb1, X[1]);
      }
#undef LDG_
      SB_();
      u16* op = (u16*)smem + 2 * BUF + (it & 1) * 2560 + 4 * h2 * 40 + r;
      float ov[2][16];
      if (dir == 0) {
#pragma unroll
        for (int rt = 0; rt < 2; ++rt)
#pragma unroll
          for (int i = 0; i < 16; ++i) ov[rt][i] = bf2f(sO[(32 * rt + (i & 3) + 8 * (i >> 2) + 4 * h2) * RS + v0 + r]);
      }
#pragma unroll
      for (int rt = 0; rt < 2; ++rt)
#pragma unroll
        for (int i = 0; i < 16; ++i) {
          float val = X[rt][i];
          if (dir == 0) val += ov[rt][i];
          op[(32 * rt + (i & 3) + 8 * (i >> 2)) * 40] = (u16)f2bf(val);
        }
    }
    SB_();
    bf16x8 fa[2][4];
#define LDT_(kt, b) do { _Pragma("unroll") for (int rt = 0; rt < 2; ++rt) _Pragma("unroll") for (int s2 = 0; s2 < 2; ++s2) { \
      const u16* a0 = sK + (32 * rt + 16 * s2 + 8 * h2 + tq) * RS + 32 * (kt) + 16 * blk + 4 * tp; fa[b][rt * 2 + s2] = cat4(tr_rd(a0), tr_rd(a0 + 4 * RS)); } } while (0)
    LDT_(0, 0);
#pragma unroll
    for (int kt = 0; kt < 4; ++kt) {
      SB_();
      if (kt < 3) LDT_(kt + 1, (kt + 1) & 1);
#pragma unroll
      for (int g = 0; g < 4; ++g) {
        const float4 d4 = *(const float4*)(sD + 32 * kt + 8 * g + 4 * h2);
        S[kt][4 * g + 0] *= d4.x; S[kt][4 * g + 1] *= d4.y; S[kt][4 * g + 2] *= d4.z; S[kt][4 * g + 3] *= d4.w;
      }
      SB_();
      S[kt] = MFMA32(fa[kt & 1][0], vb[0][0], S[kt]); S[kt] = MFMA32(fa[kt & 1][1], vb[0][1], S[kt]);
      S[kt] = MFMA32(fa[kt & 1][2], vb[1][0], S[kt]); S[kt] = MFMA32(fa[kt & 1][3], vb[1][1], S[kt]);
    }
#undef LDT_
#undef SB_
    SEQ_BAR();
  }
}

__device__ void phase4b(const Params& p, int pass, unsigned char* smem, int dry) {
  const int bid = bid_opaque();
  if (bid >= 256) return;
  const int half = bid >> 7, b7 = bid & 127, x = b7 & 7, y = b7 >> 3;
  const int vh = y & 3, chain = x + 8 * (y >> 2);
  if (half == 0) gdn_seq(p, pass, chain, vh, smem, dry);
  else hgrn_seq(p, pass, chain, vh, smem, dry);
}

__device__ void phase5(const Params& p) {
  const int tid = tid_opaque(), lane = tid & 63, gw = bid_opaque() * 8 + (tid >> 6), nw = gridDim.x * 8;
  const u16* O = (const u16*)WS_H(p);
  u16* Yn = WS_QKVB(p);
  for (int r = gw; r < MPL; r += nw) {
    const int bl = r >> 13, s = r & 8191;
    const size_t rowfull = (size_t)(bl * TOK + CTXL + s);
    u32x4 of[4], ob[4], zz[4];
#pragma unroll
    for (int it = 0; it < 4; ++it) {
      const int g = it >> 1, cg = (it & 1) * 512 + lane * 8;
      of[it] = *(const u32x4*)(O + ((size_t)(g * 2 + 0) * MPL + r) * 1024 + cg);
      ob[it] = *(const u32x4*)(O + ((size_t)(g * 2 + 1) * MPL + r) * 1024 + cg);
      zz[it] = *(const u32x4*)(WS_YZ(p) + rowfull * 2048 + g * 1024 + cg);
    }
#pragma unroll
    for (int it = 0; it < 4; ++it) {
      const int g = it >> 1, cg = (it & 1) * 512 + lane * 8;
      float o[8]; float ss = 0.f;
#pragma unroll
      for (int e = 0; e < 4; ++e) {
        const u32 a = of[it][e], b = ob[it][e];
        o[2 * e] = bf2f(a & 0xFFFFu) + bf2f(b & 0xFFFFu); o[2 * e + 1] = bf2f(a >> 16) + bf2f(b >> 16);
        ss += o[2 * e] * o[2 * e] + o[2 * e + 1] * o[2 * e + 1];
      }
      ss += __shfl_xor(ss, 1, 64); ss += __shfl_xor(ss, 2, 64); ss += __shfl_xor(ss, 4, 64); ss += __shfl_xor(ss, 8, 64);
      const float rs = rsqrtf(ss * (1.f / 128.f) + 1e-6f);
      const float* wp = (g ? p.hb_w : p.ha_w) + cg;
      const float4 w0 = *(const float4*)wp, w1 = *(const float4*)(wp + 4);
      const float wv[8] = {w0.x, w0.y, w0.z, w0.w, w1.x, w1.y, w1.z, w1.w};
      u32x4 out;
#pragma unroll
      for (int e = 0; e < 4; ++e) {
        const u32 z = zz[it][e];
        out[e] = pk2bf(bf2f(z & 0xFFFFu) * o[2 * e] * rs * wv[2 * e], bf2f(z >> 16) * o[2 * e + 1] * rs * wv[2 * e + 1]);
      }
      *(u32x4*)(Yn + (size_t)r * 2048 + g * 1024 + cg) = out;
    }
  }
}

struct Epi2 {
  static constexpr bool PERM = false, AFTER_DRAIN = false;
  const float* x; const float* mod; float* xn; int pass;
  __device__ __forceinline__ void operator()(const f32x4 (&acc)[2][2][4][2], const pg8::Unit& u, int wr, int wc, int fr, int fq) const {
    const int row0 = u.pm * 256 + wr * 64 + fr, col0 = u.pn * 256 + wc * 32 + 4 * fq;
    const int b = pass * 2 + (row0 >> 13);
    const float* gp = mod + b * 3072 + 2048 + col0;
    f32x4 gt[2][2];
#pragma unroll
    for (int bj = 0; bj < 2; ++bj)
#pragma unroll
      for (int n = 0; n < 2; ++n) gt[bj][n] = *(const f32x4*)(gp + bj * 128 + n * 16);
#pragma unroll
    for (int ai = 0; ai < 2; ++ai)
#pragma unroll
      for (int m = 0; m < 4; ++m) {
        const int r = row0 + ai * 128 + m * 16;
        const size_t grow = (size_t)b * SEQ + (r & 8191);
#pragma unroll
        for (int bj = 0; bj < 2; ++bj)
#pragma unroll
          for (int n = 0; n < 2; ++n) {
            const size_t off = grow * 1024 + col0 + bj * 128 + n * 16;
            const f32x4 xv = *(const f32x4*)(x + off);
            *(f32x4*)(xn + off) = xv + gt[bj][n] * acc[ai][bj][m][n];
          }
      }
  }
};

__device__ void phase6(const Params& p, int pass, unsigned char* smem) {
  pg8::Gemm g; g.A = WS_QKVB(p); g.Bt = WS_wtout(p); g.M = MPL; g.N = 1024; g.K = 2048;
  pg8::StaticOrder S; S.init(g.M, g.N, (int)gridDim.x, bid_opaque());
  Epi2 E; E.x = p.x; E.mod = WS_mod(p); E.xn = p.out; E.pass = pass;
  pg8::gemm_phase<Epi2, pg8::StaticOrder, false>((PG8_LAS unsigned char*)smem, g, S, E, nullptr);
}

__device__ void phase7(const Params& p) {
  const int tid = tid_opaque(), lane = tid & 63, gw = bid_opaque() * 8 + (tid >> 6), nw = gridDim.x * 8;
  for (int r = gw; r < NB * SEQ; r += 2 * nw) {
    const int r1 = r + nw;
    const bool has1 = r1 < NB * SEQ;
    float* rp0 = p.out + (size_t)r * D;
    float* rp1 = p.out + (size_t)(has1 ? r1 : r) * D;
    float4 v0[4], v1[4]; float s0 = 0.f, s1 = 0.f;
#pragma unroll
    for (int i = 0; i < 4; ++i) { v0[i] = *(const float4*)(rp0 + i * 256 + lane * 4); v1[i] = *(const float4*)(rp1 + i * 256 + lane * 4); }
#pragma unroll
    for (int i = 0; i < 4; ++i) {
      s0 += v0[i].x * v0[i].x + v0[i].y * v0[i].y + v0[i].z * v0[i].z + v0[i].w * v0[i].w;
      s1 += v1[i].x * v1[i].x + v1[i].y * v1[i].y + v1[i].z * v1[i].z + v1[i].w * v1[i].w;
    }
    s0 = wave_sum(s0); s1 = wave_sum(s1);
    const float rs0 = rsqrtf(s0 * (1.f / 1024.f) + 1e-6f), rs1 = rsqrtf(s1 * (1.f / 1024.f) + 1e-6f);
#pragma unroll
    for (int i = 0; i < 4; ++i) {
      const float4 w = *(const float4*)(p.fnw + i * 256 + lane * 4);
      float4 o; o.x = v0[i].x * rs0 * w.x; o.y = v0[i].y * rs0 * w.y; o.z = v0[i].z * rs0 * w.z; o.w = v0[i].w * rs0 * w.w;
      *(float4*)(rp0 + i * 256 + lane * 4) = o;
      if (has1) { float4 o1; o1.x = v1[i].x * rs1 * w.x; o1.y = v1[i].y * rs1 * w.y; o1.z = v1[i].z * rs1 * w.z; o1.w = v1[i].w * rs1 * w.w; *(float4*)(rp1 + i * 256 + lane * 4) = o1; }
    }
  }
}

__global__ void __launch_bounds__(512, 2) mega(Params p) {
  extern __shared__ __attribute__((aligned(16))) unsigned char smem[];
  cg::grid_group grid = cg::this_grid();
  volatile LAS unsigned* xst = (volatile LAS unsigned*)(smem + 160 * 1024 - 256);
  if (threadIdx.x == 0) { xst[0] = 0u; xst[1] = 0u; xst[2] = 0u; xst[3] = 0u; }
  __syncthreads();
  if (blockIdx.x == 0) { unsigned* bw = WS_bar(p); for (int i = threadIdx.x; i < XCD_BAR_WORDS; i += 512) bw[i] = 0u; }
  phase0(p, smem, 0);
  grid.sync();
  const XcdBarrier xb = xcd_barrier_post(WS_bar(p), xst);
  for (int pass = 0; pass < 2; ++pass) {
    Params q = p;
    {
      int z = 0; asm volatile("" : "+s"(z));
      q.ws += z; q.x += z; q.ctx += z; q.out += z; q.conv_w += z; q.norm_w += z;
    }
    phase1(q, pass);
    if (pass == 0) phase0(q, smem, 1);
    xcd_barrier(xb);
    phase2(q, smem);
    xcd_barrier(xb);
    phase3(q, smem);
    hgrn_prep(q, pass, smem, 0);
    xcd_barrier(xb);
    gdn_prep(q, pass, smem);
    xcd_barrier(xb);
    phase4b(q, pass, smem, 0);
    xcd_barrier(xb);
    phase5(q);
    xcd_barrier(xb);
    phase6(q, pass, smem);
  }
  xcd_barrier(xb);
  phase7(p);
}

extern "C" void kernel_launch(void* const* d_in, const int* in_sizes, int n_in, void* d_out,
                              int out_size, void* d_ws, size_t ws_size, hipStream_t stream) {
  constexpr size_t kDynLds = 160 * 1024;
  static int grid_blocks = 0;
  if (!grid_blocks) {
    hipFuncSetAttribute((const void*)mega, hipFuncAttributeMaxDynamicSharedMemorySize, (int)kDynLds);
    int dev = 0, cus = 0, per_cu = 0;
    hipGetDevice(&dev);
    hipDeviceGetAttribute(&cus, hipDeviceAttributeMultiprocessorCount, dev);
    hipOccupancyMaxActiveBlocksPerMultiprocessor(&per_cu, mega, 512, kDynLds);
    if (per_cu > 1) per_cu = 1;
    grid_blocks = cus * per_cu;
  }
  Params p{};
  p.x = (const float*)d_in[0]; p.c = (const float*)d_in[1]; p.ctx = (const float*)d_in[2]; p.c_ctx = (const float*)d_in[3];
  p.norm_w = (const float*)d_in[4]; p.ada_w = (const float*)d_in[5]; p.ada_b = (const float*)d_in[6]; p.w_in = (const float*)d_in[7];
  p.conv_w = (const float*)d_in[8]; p.lb_logits = (const float*)d_in[9]; p.a_log = (const float*)d_in[10]; p.dt_bias = (const float*)d_in[11];
  p.ha_w = (const float*)d_in[12]; p.hb_w = (const float*)d_in[13]; p.w_out = (const float*)d_in[14]; p.fnw = (const float*)d_in[15];
  p.out = (float*)d_out;
  p.ws = (unsigned char*)d_ws;
  void* args[] = {&p};
  hipError_t e = hipLaunchCooperativeKernel((void*)mega, dim3(grid_blocks), dim3(512), args, kDynLds, stream);
  if (e != hipSuccess) fprintf(stderr, "cooperative launch failed: %s (grid %d)\n", hipGetErrorString(e), grid_blocks);
}
```

```cpp
#include <hip/hip_runtime.h>
#include <hip/hip_cooperative_groups.h>
#include <cstdio>
namespace cg = cooperative_groups;
__device__ __forceinline__ int tid_opaque() { int t = (int)threadIdx.x; asm volatile("" : "+v"(t)); return t; }
__device__ __forceinline__ int bid_opaque() { int t = (int)blockIdx.x; asm volatile("" : "+s"(t)); return t; }
#include <hip/hip_runtime.h>
#include <cstdio>
#include <cstdint>
#include <cstdlib>
#include <vector>

#define XB_TMO      128
#define XB_XCNT(j)  (256  + 64 * (j))
#define XB_XSUB(j)  (1280 + 64 * (j))
#define XB_XGEN(j)  (2304 + 64 * (j))
#define XB_TOP      3328
#define XB_TOPGEN   3392
#define XCD_BAR_WORDS 3456
#define XB_SPIN_CAP (1u << 18)
#define LAS __attribute__((address_space(3)))

__device__ __forceinline__ unsigned xb_ld(unsigned* p)              { return __hip_atomic_load(p, __ATOMIC_RELAXED, __HIP_MEMORY_SCOPE_AGENT); }
__device__ __forceinline__ unsigned xb_add(unsigned* p, unsigned v) { return __hip_atomic_fetch_add(p, v, __ATOMIC_RELAXED, __HIP_MEMORY_SCOPE_AGENT); }
__device__ __forceinline__ unsigned xb_xcc_id() { return (unsigned)__builtin_amdgcn_s_getreg((3 << 11) | 20) & 0xFu; }
#define XB_SPIN(cond, bar) do { unsigned _sp = 0; while (cond) { __builtin_amdgcn_s_sleep(1); \
    if ((++_sp & 255u) == 0u) { if (xb_ld(&(bar)[XB_TMO])) break; if (_sp > XB_SPIN_CAP) { atomicAdd(&(bar)[XB_TMO], 1u); break; } } } } while (0)

struct XcdBarrier {
    unsigned* bar; unsigned x;
    volatile LAS unsigned* st;
};

__device__ __forceinline__ XcdBarrier xcd_barrier_post(unsigned* bar, volatile LAS unsigned* st) {
    XcdBarrier b; b.bar = bar; b.x = xb_xcc_id(); b.st = st;
    if (threadIdx.x == 0) (void)xb_add(&bar[XB_XCNT(b.x)], 1u);
    return b;
}
__device__ __forceinline__ void xcd_barrier_complete(unsigned* bar, unsigned x, unsigned& nloc, unsigned& nx) {
    const unsigned G = gridDim.x * gridDim.y * gridDim.z;
    unsigned sum, cnt, mine, sp = 0u;
    for (;;) {
        sum = 0u; cnt = 0u; mine = 0u;
#pragma unroll
        for (unsigned j = 0; j < 16; ++j) { const unsigned c = xb_ld(&bar[XB_XCNT(j)]); sum += c; cnt += (c > 0u) ? 1u : 0u; mine = (j == x) ? c : mine; }
        if (sum == G) break;
        __builtin_amdgcn_s_sleep(1);
        if ((++sp & 255u) == 0u) { if (xb_ld(&bar[XB_TMO])) break; if (sp > XB_SPIN_CAP) { atomicAdd(&bar[XB_TMO], 1u); break; } }
    }
    nloc = mine > 0u ? mine : 1u; nx = cnt > 0u ? cnt : 1u;
}

__device__ __forceinline__ void xcd_barrier(const XcdBarrier& b) {
    asm volatile("s_waitcnt vmcnt(0)" ::: "memory");
    __syncthreads();
    if (threadIdx.x == 0) {
        unsigned* bar = b.bar;
        __builtin_amdgcn_s_waitcnt(0);
        unsigned nloc = b.st[0], nx = b.st[1];
        if (nloc == 0u) { xcd_barrier_complete(bar, b.x, nloc, nx); b.st[0] = nloc; b.st[1] = nx; }
        const unsigned old = xb_add(&bar[XB_XSUB(b.x)], 1u);
        const unsigned gen = old / nloc;
        if (old + 1u == (gen + 1u) * nloc) {
            __builtin_amdgcn_fence(__ATOMIC_RELEASE, "agent");
            asm volatile("s_waitcnt vmcnt(0)" ::: "memory");
            const unsigned og = xb_add(&bar[XB_TOP], 1u);
            const unsigned tg = og / nx;
            if (og + 1u == (tg + 1u) * nx) xb_add(&bar[XB_TOPGEN], 1u);
            else XB_SPIN(xb_ld(&bar[XB_TOPGEN]) == tg, bar);
            __builtin_amdgcn_fence(__ATOMIC_ACQUIRE, "agent");
            xb_add(&bar[XB_XGEN(b.x)], 1u);
            asm volatile("s_waitcnt vmcnt(0)" ::: "memory");
        } else {
            XB_SPIN(xb_ld(&bar[XB_XGEN(b.x)]) == gen, bar);
            __builtin_amdgcn_fence(__ATOMIC_ACQUIRE, "agent");
            asm volatile("s_waitcnt vmcnt(0)" ::: "memory");
        }
    }
    __syncthreads();
}
namespace pg8 {
#define PG8_LAS __attribute__((address_space(3)))
typedef unsigned short bf16_t;
typedef short bf16x8 __attribute__((ext_vector_type(8)));
typedef float f32x4 __attribute__((ext_vector_type(4)));
typedef unsigned u32x4 __attribute__((ext_vector_type(4)));
constexpr int BM = 256, BK = 64, HALF = 128, HTB = HALF * BK * 2  , STAGE_BYTES = 8 * HTB, NXCD = 8, WGM = 4;

__host__ __device__ __forceinline__ int lds_byte(int r, int c) { const int st = (r >> 4) * 2 + (c >> 5), rr = r & 15, cc = c & 31, ob = rr * 64 + cc * 2; return st * 1024 + (ob ^ (((ob >> 9) & 1) << 5)); }
__host__ __device__ __forceinline__ void stage_rc(int b, int& R, int& C) { const int st = b / 1024, sb = b % 1024, swz = sb ^ (((sb >> 9) & 1) << 5); R = (st >> 1) * 16 + swz / 64; C = (st & 1) * 32 + (swz % 64) / 2; }
__host__ __device__ __forceinline__ int perm32(int rho) { const int n = rho >> 4, i = rho & 15; return 8 * (i >> 2) + 4 * n + (i & 3); }

struct Unit { int pm, pn; };
struct Gemm { const bf16_t* A; const bf16_t* Bt; int M, N, K; };

struct StaticOrder {
    int nM, nN, nwg, G, c;
    __host__ __device__ void init(int M, int N, int G_, int c_) { nM = M / BM; nN = N / BM; nwg = nM * nN; G = G_; c = c_; }
    __host__ __device__ bool next(int i, Unit& u) const {
        const long L = (long)i * G + c; if (L >= nwg) return false;
        int wgid = (int)L; { const int q = nwg / NXCD, r = nwg % NXCD, xcd = wgid % NXCD, off = wgid / NXCD; wgid = (xcd < r ? xcd * (q + 1) : r * (q + 1) + (xcd - r) * q) + off; }
        const int nig = WGM * nN, gid = wgid / nig, fm = gid * WGM, gsz = (nM - fm) < WGM ? (nM - fm) : WGM;
        u.pm = fm + ((wgid % nig) % gsz); u.pn = (wgid % nig) / gsz; return true;
    }
    __device__ __forceinline__ void a_ready(const Unit&) const {}
    __device__ __forceinline__ void done(const Unit&) const {}
};

__device__ __forceinline__ unsigned cvt_pk_bf16(float lo, float hi) { unsigned r; asm volatile("v_cvt_pk_bf16_f32 %0, %1, %2" : "=v"(r) : "v"(lo), "v"(hi)); return r; }
typedef float f32x2 __attribute__((ext_vector_type(2)));

template <class Epi, class Sched, bool STAMP = false>
__device__ __forceinline__ void gemm_phase(PG8_LAS unsigned char* lds, const Gemm g, const Sched& S, const Epi& E, unsigned long long* stamps) {
    const int tid = ::tid_opaque(), wid = __builtin_amdgcn_readfirstlane(tid >> 6), lane = tid & 63, wr = wid >> 2, wc = wid & 3, fr = lane & 15, fq = lane >> 4;
    const int K = g.K, nt = K / BK;
    int ts_lo = 0, ts_hi = 0, nts = 0; const unsigned long long rt_entry = STAMP ? (unsigned long long)wall_clock64() : 0ull;
#define PG8_STAMP() do { if (STAMP && wid == 0 && nts < 64) { const unsigned long long _c = (unsigned long long)clock64(); \
        ts_lo = (lane == nts) ? (int)(unsigned)_c : ts_lo; ts_hi = (lane == nts) ? (int)(unsigned)(_c >> 32) : ts_hi; ++nts; } } while (0)
    PG8_STAMP();
    unsigned voffA[2], voffB[2];
#pragma unroll
    for (int i = 0; i < 2; ++i) { int R, C; stage_rc(tid * 16 + i * 8192, R, C); const int Rb = Epi::PERM ? ((R & ~31) + perm32(R & 31)) : R;
        voffA[i] = (unsigned)(R * K + C) * 2u; voffB[i] = (unsigned)(Rb * K + C) * 2u; }
    const size_t kstep = (size_t)(BK * 2);
    const size_t hstep = (size_t)HALF * K * 2;
    const size_t tstep = 2 * hstep;
    const unsigned ldsw = (unsigned)wid * 1024u;
    const int aoff = lds_byte(wr * 64 + fr, fq * 8), boff = lds_byte(wc * 32 + fr, fq * 8);
#define PG8_SA(b, h) (((b) * 2 + (h)) * HTB)
#define PG8_SB(b, h) ((4 + (b) * 2 + (h)) * HTB)
#define PG8_STAGE(bufoff, gbase, voff) do { _Pragma("unroll") for (int _i = 0; _i < 2; ++_i) \
        __builtin_amdgcn_global_load_lds((const unsigned*)((const char*)(gbase) + (voff)[_i]), (PG8_LAS unsigned*)(lds + (bufoff) + ldsw + _i * 8192), 16, 0, 0); } while (0)
#define PG8_LDA(dst, b, h) do { _Pragma("unroll") for (int m = 0; m < 4; ++m) _Pragma("unroll") for (int k = 0; k < 2; ++k) dst[m][k] = *(const PG8_LAS bf16x8*)(lds + PG8_SA(b, h) + aoff + m * 2048 + k * 1024); } while (0)
#define PG8_LDB(dst, b, h) do { _Pragma("unroll") for (int n = 0; n < 2; ++n) _Pragma("unroll") for (int k = 0; k < 2; ++k) dst[n][k] = *(const PG8_LAS bf16x8*)(lds + PG8_SB(b, h) + boff + n * 2048 + k * 1024); } while (0)
#define PG8_MMA(ai, bj, At, Bt) do { __builtin_amdgcn_s_setprio(1); _Pragma("unroll") for (int m = 0; m < 4; ++m) _Pragma("unroll") for (int n = 0; n < 2; ++n) _Pragma("unroll") for (int k = 0; k < 2; ++k) \
        acc[ai][bj][m][n] = __builtin_amdgcn_mfma_f32_16x16x32_bf16(Bt[n][k], At[m][k], acc[ai][bj][m][n], 0, 0, 0); __builtin_amdgcn_s_setprio(0); } while (0)
#define PG8_WAIT_V(n) asm volatile("s_waitcnt vmcnt(" #n ")" ::: "memory")
#define PG8_WAIT_L(n) asm volatile("s_waitcnt lgkmcnt(" #n ")" ::: "memory")
#define PG8_BAR __builtin_amdgcn_s_barrier()
#define PG8_SCHED __builtin_amdgcn_sched_barrier(0)
    Unit cur, nxt; int ui = 0;
    if (!S.next(0, cur)) return;
    f32x4 acc[2][2][4][2];
#pragma unroll
    for (int a = 0; a < 2; ++a)
#pragma unroll
        for (int b = 0; b < 2; ++b)
#pragma unroll
            for (int m = 0; m < 4; ++m)
#pragma unroll
                for (int n = 0; n < 2; ++n) acc[a][b][m][n] = (f32x4){0.f, 0.f, 0.f, 0.f};
    bf16x8 At[4][2], B0[2][2], B1[2][2];
    const char* cA = (const char*)g.A + (size_t)cur.pm * tstep; const char* cB = (const char*)g.Bt + (size_t)cur.pn * tstep;
    S.a_ready(cur);
    PG8_STAGE(PG8_SB(0, 0), cB, voffB); PG8_STAGE(PG8_SA(0, 0), cA, voffA); PG8_STAGE(PG8_SB(0, 1), cB + hstep, voffB); PG8_STAGE(PG8_SA(0, 1), cA + hstep, voffA);
    if (wr == 1) PG8_BAR;
    PG8_WAIT_V(4); PG8_BAR;
    PG8_STAGE(PG8_SB(1, 0), cB + kstep, voffB); PG8_STAGE(PG8_SA(1, 0), cA + kstep, voffA); PG8_STAGE(PG8_SB(1, 1), cB + hstep + kstep, voffB);
    PG8_WAIT_V(6); PG8_BAR;
    PG8_STAMP();
    for (;;) {
        const bool has_next = S.next(ui + 1, nxt);
        const char* nA = has_next ? (const char*)g.A + (size_t)nxt.pm * tstep : cA; const char* nB = has_next ? (const char*)g.Bt + (size_t)nxt.pn * tstep : cB;
        for (int t = 0; t < nt; t += 2) {
            const bool last = (t == nt - 2);
            const char* a1 = cA + (size_t)(t + 1) * kstep;
            const char* a2 = last ? nA : cA + (size_t)(t + 2) * kstep; const char* b2 = last ? nB : cB + (size_t)(t + 2) * kstep;
            const char* a3 = a2 + kstep; const char* b3 = b2 + kstep;
            if (last && has_next) S.a_ready(nxt);
            PG8_LDB(B0, 0, 0); PG8_SCHED; PG8_LDA(At, 0, 0); PG8_STAGE(PG8_SA(1, 1), a1 + hstep, voffA);
            PG8_WAIT_L(8); PG8_BAR; PG8_WAIT_L(0); PG8_MMA(0, 0, At, B0); PG8_BAR; PG8_SCHED;
            PG8_LDB(B1, 0, 1); PG8_STAGE(PG8_SB(0, 0), b2, voffB);
            PG8_BAR; PG8_WAIT_L(0); PG8_MMA(0, 1, At, B1); PG8_BAR;
            PG8_LDA(At, 0, 1); PG8_STAGE(PG8_SA(0, 0), a2, voffA);
            PG8_BAR; PG8_WAIT_L(0); PG8_MMA(1, 0, At, B0); PG8_BAR; PG8_SCHED;
            PG8_STAGE(PG8_SB(0, 1), b2 + hstep, voffB);
            PG8_WAIT_V(6); PG8_BAR; PG8_MMA(1, 1, At, B1); PG8_BAR;
            PG8_LDB(B0, 1, 0); PG8_SCHED; PG8_LDA(At, 1, 0); PG8_STAGE(PG8_SA(0, 1), a2 + hstep, voffA);
            PG8_WAIT_L(8); PG8_BAR; PG8_WAIT_L(0); PG8_MMA(0, 0, At, B0); PG8_BAR; PG8_SCHED;
            PG8_LDB(B1, 1, 1); PG8_STAGE(PG8_SB(1, 0), b3, voffB);
            PG8_BAR; PG8_WAIT_L(0); PG8_MMA(0, 1, At, B1); PG8_BAR;
            PG8_LDA(At, 1, 1); PG8_STAGE(PG8_SA(1, 0), a3, voffA);
            PG8_BAR; PG8_WAIT_L(0); PG8_MMA(1, 0, At, B0); PG8_BAR; PG8_SCHED;
            PG8_STAGE(PG8_SB(1, 1), b3 + hstep, voffB);
            PG8_WAIT_V(6); PG8_BAR; PG8_MMA(1, 1, At, B1); PG8_BAR;
        }
        PG8_STAMP();
        if constexpr (!Epi::AFTER_DRAIN) { E(acc, cur, wr, wc, fr, fq); S.done(cur); }
        PG8_STAMP();
        if (!has_next) break;
#pragma unroll
        for (int a = 0; a < 2; ++a)
#pragma unroll
            for (int b = 0; b < 2; ++b)
#pragma unroll
                for (int m = 0; m < 4; ++m)
#pragma unroll
                    for (int n = 0; n < 2; ++n) acc[a][b][m][n] = (f32x4){0.f, 0.f, 0.f, 0.f};
        cur = nxt; cA = nA; cB = nB; ++ui;
    }
    PG8_WAIT_V(0);
    if (wr == 0) PG8_BAR;
    PG8_BAR;
    if constexpr (Epi::AFTER_DRAIN) { E.fused(acc, cur, wr, wc, fr, fq, lds, wid, lane); S.done(cur); }
    PG8_STAMP();
    if (STAMP && wid == 0) { stamps[lane] = lane < nts ? (((unsigned long long)(unsigned)ts_hi << 32) | (unsigned)ts_lo) : 0ull;
        if (lane == 62) stamps[62] = rt_entry; if (lane == 63) stamps[63] = (unsigned long long)wall_clock64(); }
#undef PG8_STAMP
#undef PG8_SA
#undef PG8_SB
#undef PG8_STAGE
#undef PG8_LDA
#undef PG8_LDB
#undef PG8_MMA
#undef PG8_WAIT_V
#undef PG8_WAIT_L
#undef PG8_BAR
#undef PG8_SCHED
}
}

typedef unsigned short u16;
typedef unsigned int u32;
using pg8::f32x4;
using pg8::bf16x8;
using pg8::u32x4;

constexpr int D = 1024, NB = 4, SEQ = 8192, CTXL = 256, TOK = SEQ + CTXL;
constexpr int NIN = 9248;
constexpr int MP = 2 * TOK;
constexpr int MPL = 2 * SEQ;

struct Params {
  const float *x, *c, *ctx, *c_ctx, *norm_w, *ada_w, *ada_b, *w_in, *conv_w, *lb_logits, *a_log, *dt_bias, *ha_w, *hb_w, *w_out, *fnw;
  float* out;
  unsigned char* ws;
};
constexpr size_t ws_up(size_t b) { return (b + 255) & ~(size_t)255; }
constexpr size_t OFF_mod = 0;
constexpr size_t OFF_lbv = OFF_mod + ws_up(5 * 3072 * 4);
constexpr size_t OFF_wtin = OFF_lbv + ws_up(2048 * 4);
constexpr size_t OFF_wtout = OFF_wtin + ws_up((size_t)NIN * 1024 * 2);
constexpr size_t OFF_H = OFF_wtout + ws_up((size_t)1024 * 2048 * 2);
constexpr size_t OFF_YB = OFF_H + ws_up((size_t)MP * 1024 * 2);
constexpr size_t OFF_YA = OFF_YB + ws_up((size_t)MP * 3072 * 2);
constexpr size_t OFF_YZ = OFF_YA + ws_up((size_t)MP * 4096 * 2);
constexpr size_t OFF_AB = OFF_YZ + ws_up((size_t)MP * 2048 * 2);
constexpr size_t OFF_QKVB = OFF_AB + ws_up((size_t)MP * 32 * 4);
constexpr size_t OFF_TPf = OFF_QKVB + ws_up((size_t)MP * 3072 * 2);
constexpr size_t OFF_TPb = OFF_TPf + ws_up((size_t)2112 * 4096 * 2);
constexpr size_t OFF_PPf = OFF_TPb + ws_up((size_t)2112 * 4096 * 2);
constexpr size_t OFF_GS = OFF_PPf + ws_up((size_t)2112 * 4096 * 2);
constexpr size_t OFF_DL = OFF_GS + ws_up((size_t)4224 * 256 * 4);
constexpr size_t OFF_bar = OFF_DL + ws_up((size_t)4224 * 128 * 4);
constexpr size_t WS_TOTAL = OFF_bar + ws_up((size_t)XCD_BAR_WORDS * 4);
#define WS_mod(p) ((float*)((p).ws + OFF_mod))
#define WS_lbv(p) ((float*)((p).ws + OFF_lbv))
#define WS_wtin(p) ((u16*)((p).ws + OFF_wtin))
#define WS_wtout(p) ((u16*)((p).ws + OFF_wtout))
#define WS_H(p) ((u16*)((p).ws + OFF_H))
#define WS_YB(p) ((u16*)((p).ws + OFF_YB))
#define WS_YA(p) ((u16*)((p).ws + OFF_YA))
#define WS_YZ(p) ((u16*)((p).ws + OFF_YZ))
#define WS_AB(p) ((float*)((p).ws + OFF_AB))
#define WS_QKVB(p) ((u16*)((p).ws + OFF_QKVB))
#define WS_TPf(p) ((u16*)((p).ws + OFF_TPf))
#define WS_TPb(p) ((u16*)((p).ws + OFF_TPb))
#define WS_PPf(p) ((u16*)((p).ws + OFF_PPf))
#define WS_GS(p) ((float*)((p).ws + OFF_GS))
#define WS_DL(p) ((float*)((p).ws + OFF_DL))
#define WS_bar(p) ((unsigned*)((p).ws + OFF_bar))


__device__ __forceinline__ float bf2f(u32 b) { return __uint_as_float(b << 16); }
typedef __bf16 hwbf16x2 __attribute__((ext_vector_type(2)));
typedef float hwf32x2 __attribute__((ext_vector_type(2)));
__device__ __forceinline__ u32 pk2bf(float lo, float hi) { const hwf32x2 v = {lo, hi}; return __builtin_bit_cast(u32, __builtin_convertvector(v, hwbf16x2)); }
__device__ __forceinline__ u32 f2bf(float f) { return pk2bf(f, f) & 0xFFFFu; }
__device__ __forceinline__ float h2f(u32 b) { return (float)__builtin_bit_cast(_Float16, (u16)b); }
__device__ __forceinline__ u32 f2h(float f) { return (u32)__builtin_bit_cast(u16, (_Float16)f); }
__device__ __forceinline__ float wave_sum(float v) {
#pragma unroll
  for (int o = 32; o >= 1; o >>= 1) v += __shfl_xor(v, o, 64);
  return v;
}
__device__ __forceinline__ float sigmoidf_(float x) { return __builtin_amdgcn_rcpf(1.f + __expf(-x)); }
__device__ __forceinline__ float siluf_(float x) { return x * __builtin_amdgcn_rcpf(1.f + __expf(-x)); }

__device__ void transpose_tile(const float* __restrict__ src, int K, int N, u16* __restrict__ dst, int kt, int nt, float* tile) {
  const int tid = tid_opaque();
#pragma unroll
  for (int i = 0; i < 2; ++i) {
    const int kk = (tid >> 4) + 32 * i, n4 = (tid & 15) * 4, n = nt * 64 + n4;
    float4 v = make_float4(0.f, 0.f, 0.f, 0.f);
    if (n < N) v = *(const float4*)(src + (size_t)(kt * 64 + kk) * N + n);
    float* t = tile + kk * 65 + n4; t[0] = v.x; t[1] = v.y; t[2] = v.z; t[3] = v.w;
  }
  __syncthreads();
  {
    const int n = tid >> 3, k8 = (tid & 7) * 8;
    if (nt * 64 + n < N) {
      u32x4 w;
      w.x = pk2bf(tile[(k8 + 0) * 65 + n], tile[(k8 + 1) * 65 + n]);
      w.y = pk2bf(tile[(k8 + 2) * 65 + n], tile[(k8 + 3) * 65 + n]);
      w.z = pk2bf(tile[(k8 + 4) * 65 + n], tile[(k8 + 5) * 65 + n]);
      w.w = pk2bf(tile[(k8 + 6) * 65 + n], tile[(k8 + 7) * 65 + n]);
      *(u32x4*)(dst + (size_t)(nt * 64 + n) * K + kt * 64 + k8) = w;
    }
  }
  __syncthreads();
}

__device__ void phase0(const Params& p, unsigned char* smem, int part) {
  const int tid = tid_opaque(), nb = gridDim.x, bid = bid_opaque();
  float* sm = (float*)smem;
  constexpr int T_ADA = 48, T_WIN = 16 * 145, T_WOUT = 32 * 16;
  constexpr int NT = T_ADA + T_WIN + T_WOUT + 1;
  for (int task = bid; task < NT; task += nb) {
    const bool isT = task >= T_ADA && task < T_ADA + T_WIN + T_WOUT;
    if (isT != (part == 1)) continue;
    if (task < T_ADA) {
      float* s_c = sm;
      float* s_red = sm + 5 * 1024;
      for (int i = tid; i < 5 * 1024; i += 512) { const int j = i >> 10, d = i & 1023; const float v = (j < 4) ? p.c[j * 1024 + d] : p.c_ctx[d]; s_c[i] = siluf_(v); }
      __syncthreads();
      const int cl = tid & 63, col = task * 64 + cl, ks = tid >> 6;
      float a0 = 0.f, a1 = 0.f, a2 = 0.f, a3 = 0.f, a4 = 0.f;
      const float* wp = p.ada_w + (size_t)(ks * 128) * 3072 + col;
#pragma unroll 1
      for (int d0 = 0; d0 < 128; d0 += 32) {
        float wv[32];
#pragma unroll
        for (int e = 0; e < 32; ++e) wv[e] = wp[(size_t)(d0 + e) * 3072];
#pragma unroll
        for (int e = 0; e < 32; ++e) { const float w = wv[e]; const int dd = ks * 128 + d0 + e;
          a0 += s_c[dd] * w; a1 += s_c[1024 + dd] * w; a2 += s_c[2048 + dd] * w; a3 += s_c[3072 + dd] * w; a4 += s_c[4096 + dd] * w; }
      }
      for (int d = 128; d < 128; ++d) {
        const float w = wp[(size_t)d * 3072]; const int dd = ks * 128 + d;
        a0 += s_c[dd] * w; a1 += s_c[1024 + dd] * w; a2 += s_c[2048 + dd] * w; a3 += s_c[3072 + dd] * w; a4 += s_c[4096 + dd] * w;
      }
      s_red[(ks * 5 + 0) * 64 + cl] = a0; s_red[(ks * 5 + 1) * 64 + cl] = a1; s_red[(ks * 5 + 2) * 64 + cl] = a2;
      s_red[(ks * 5 + 3) * 64 + cl] = a3; s_red[(ks * 5 + 4) * 64 + cl] = a4;
      __syncthreads();
      if (tid < 320) {
        const int j = tid >> 6, cc = tid & 63; float s = 0.f;
#pragma unroll
        for (int k = 0; k < 8; ++k) s += s_red[(k * 5 + j) * 64 + cc];
        WS_mod(p)[j * 3072 + task * 64 + cc] = s + p.ada_b[task * 64 + cc];
      }
      __syncthreads();
    } else if (task < T_ADA + T_WIN) {
      const int t = task - T_ADA; transpose_tile(p.w_in, 1024, NIN, WS_wtin(p), t % 16, t / 16, sm);
    } else if (task < T_ADA + T_WIN + T_WOUT) {
      const int t = task - T_ADA - T_WIN; transpose_tile(p.w_out, 2048, 1024, WS_wtout(p), t % 32, t / 32, sm);
    } else {
      for (int i = tid; i < 2048; i += 512) { const float l0 = p.lb_logits[i], l1 = p.lb_logits[2048 + i]; WS_lbv(p)[i] = 1.f / (1.f + __expf(l1 - l0)); }
    }
  }
}

__device__ void phase1(const Params& p, int pass) {
  const int tid = tid_opaque(), lane = tid & 63, gw = bid_opaque() * 8 + (tid >> 6), nw = gridDim.x * 8;
  for (int r = gw; r < MP; r += nw) {
    const int bl = r / TOK, tau = r - bl * TOK, b = pass * 2 + bl;
    const float* src; int j;
    if (tau < CTXL) { src = p.ctx + ((size_t)b * CTXL + tau) * D; j = 4; } else { src = p.x + ((size_t)b * SEQ + (tau - CTXL)) * D; j = b; }
    float4 v[4]; float ss = 0.f;
#pragma unroll
    for (int i = 0; i < 4; ++i) { v[i] = *(const float4*)(src + i * 256 + lane * 4); ss += v[i].x * v[i].x + v[i].y * v[i].y + v[i].z * v[i].z + v[i].w * v[i].w; }
    ss = wave_sum(ss);
    const float rstd = rsqrtf(ss * (1.f / 1024.f) + 1e-6f);
    const float* md = WS_mod(p) + j * 3072;
#pragma unroll
    for (int i = 0; i < 4; ++i) {
      const int d = i * 256 + lane * 4;
      const float4 nw4 = *(const float4*)(p.norm_w + d), sh = *(const float4*)(md + d), sc = *(const float4*)(md + 1024 + d);
      const float h0 = v[i].x * rstd * nw4.x * (1.f + sc.x) + sh.x, h1 = v[i].y * rstd * nw4.y * (1.f + sc.y) + sh.y;
      const float h2 = v[i].z * rstd * nw4.z * (1.f + sc.z) + sh.z, h3 = v[i].w * rstd * nw4.w * (1.f + sc.w) + sh.w;
      uint2 o; o.x = pk2bf(h0, h1); o.y = pk2bf(h2, h3);
      *(uint2*)(WS_H(p) + (size_t)r * D + d) = o;
    }
  }
}

template <int MODE> __device__ __forceinline__ void epi1_store(const f32x4 (&acc)[2][2][4][2], u16* base, int ld, int row0, int col0, const float* lbp) {
  float lb[2][8];
  if (MODE == 1) {
#pragma unroll
    for (int bj = 0; bj < 2; ++bj)
#pragma unroll
      for (int e = 0; e < 8; ++e) lb[bj][e] = lbp[col0 + bj * 128 + e];
  }
#pragma unroll
  for (int ai = 0; ai < 2; ++ai)
#pragma unroll
    for (int m = 0; m < 4; ++m) {
      u16* rowp = base + (size_t)(row0 + ai * 128 + m * 16) * ld + col0;
#pragma unroll
      for (int bj = 0; bj < 2; ++bj) {
        float v[8];
#pragma unroll
        for (int e = 0; e < 4; ++e) { v[e] = acc[ai][bj][m][0][e]; v[4 + e] = acc[ai][bj][m][1][e]; }
        float t[8];
#pragma unroll
        for (int e = 0; e < 8; ++e) {
          if (MODE == 0) t[e] = siluf_(v[e]) * 0.08838834764831845f;
          else if (MODE == 1) { const float l = lb[bj][e]; t[e] = __logf(l + (1.f - l) * sigmoidf_(v[e])); }
          else if (MODE == 2) t[e] = v[e];
          else t[e] = siluf_(v[e]);
        }
        u32x4 w;
        if (MODE == 1) { w.x = f2h(t[0]) | (f2h(t[1]) << 16); w.y = f2h(t[2]) | (f2h(t[3]) << 16); w.z = f2h(t[4]) | (f2h(t[5]) << 16); w.w = f2h(t[6]) | (f2h(t[7]) << 16); }
        else { w.x = pk2bf(t[0], t[1]); w.y = pk2bf(t[2], t[3]); w.z = pk2bf(t[4], t[5]); w.w = pk2bf(t[6], t[7]); }
        *(u32x4*)(rowp + bj * 128) = w;
      }
    }
}

struct Epi1 {
  static constexpr bool PERM = true, AFTER_DRAIN = false;
  u16 *YA, *YZ, *YB; const float* lbv;
  __device__ __forceinline__ void operator()(const f32x4 (&acc)[2][2][4][2], const pg8::Unit& u, int wr, int wc, int fr, int fq) const {
    const int seg = u.pn >> 2, cseg = (u.pn & 3) * 256;
    const int row0 = u.pm * 256 + wr * 64 + fr, col0 = cseg + wc * 32 + 8 * fq;
    if (seg == 0) epi1_store<0>(acc, YA, 4096, row0, col0, lbv);
    else if (seg == 1) epi1_store<1>(acc, YA + 1024, 4096, row0, col0, lbv);
    else if (seg == 2) epi1_store<1>(acc, YA + 2048, 4096, row0, col0, lbv + 1024);
    else if (seg == 3) epi1_store<2>(acc, YA + 3072, 4096, row0, col0, lbv);
    else if (seg == 4) epi1_store<3>(acc, YZ, 2048, row0, col0, lbv);
    else if (seg <= 7) epi1_store<2>(acc, YB + (seg - 5) * 1024, 3072, row0, col0, lbv);
    else epi1_store<3>(acc, YZ + 1024, 2048, row0, col0, lbv);
  }
};

__device__ void phase2(const Params& p, unsigned char* smem) {
  {
    pg8::Gemm g; g.A = WS_H(p); g.Bt = WS_wtin(p); g.M = MP; g.N = 9216; g.K = 1024;
    pg8::StaticOrder S; S.init(g.M, g.N, (int)gridDim.x, bid_opaque());
    Epi1 E; E.YA = WS_YA(p); E.YZ = WS_YZ(p); E.YB = WS_YB(p); E.lbv = WS_lbv(p);
    pg8::gemm_phase<Epi1, pg8::StaticOrder, false>((PG8_LAS unsigned char*)smem, g, S, E, nullptr);
  }
  const int tid = tid_opaque(), lane = tid & 63, gw = bid_opaque() * 8 + (tid >> 6), nw = gridDim.x * 8;
  const int fr = lane & 15, quad = lane >> 4;
  const int nbig = (MP / 256) * 36 - 9 * (int)gridDim.x;
  const bool bal = (gridDim.x == 256);
  if (bal && (int)(gw >> 3) < nbig) return;
  const int gw2 = bal ? gw - nbig * 8 : gw, nw2 = bal ? nw - nbig * 8 : nw;
  for (int t = gw2; t < MP / 16; t += nw2) {
    f32x4 acc0 = {0.f, 0.f, 0.f, 0.f}, acc1 = {0.f, 0.f, 0.f, 0.f};
    const u16* ap = WS_H(p) + (size_t)(t * 16 + fr) * 1024 + quad * 8;
    const u16* b0 = WS_wtin(p) + (size_t)(9216 + fr) * 1024 + quad * 8;
    const u16* b1 = b0 + 16 * 1024;
#pragma unroll 4
    for (int k0 = 0; k0 < 1024; k0 += 32) {
      const bf16x8 a = *(const bf16x8*)(ap + k0), bb0 = *(const bf16x8*)(b0 + k0), bb1 = *(const bf16x8*)(b1 + k0);
      acc0 = __builtin_amdgcn_mfma_f32_16x16x32_bf16(a, bb0, acc0, 0, 0, 0);
      acc1 = __builtin_amdgcn_mfma_f32_16x16x32_bf16(a, bb1, acc1, 0, 0, 0);
    }
    const float ea = __expf(p.a_log[fr]), dtb = p.dt_bias[fr];
#pragma unroll
    for (int j = 0; j < 4; ++j) {
      const int r = t * 16 + quad * 4 + j;
      const float xx = acc0[j] + dtb;
      const float sp = xx > 20.f ? xx : log1pf(__expf(xx));
      WS_AB(p)[(size_t)r * 32 + fr] = -ea * sp;
      WS_AB(p)[(size_t)r * 32 + 16 + fr] = sigmoidf_(acc1[j]);
    }
  }
}

__device__ __forceinline__ void conv_taps(int r, int nbr[9], float vm[9]) {
  const int bl = r / TOK, tau = r - bl * TOK;
#pragma unroll
  for (int dh = 0; dh < 3; ++dh)
#pragma unroll
    for (int dw = 0; dw < 3; ++dw) {
      bool valid; int nb;
      if (tau < CTXL) { const int t2 = tau + dw - 1; valid = (dh == 1) && t2 >= 0 && t2 < CTXL; nb = t2; }
      else { const int sidx = tau - CTXL, r2 = (sidx >> 6) + dh - 1, c2 = (sidx & 63) + dw - 1; valid = r2 >= 0 && r2 < 128 && c2 >= 0 && c2 < 64; nb = CTXL + r2 * 64 + c2; }
      nbr[dh * 3 + dw] = bl * TOK + (valid ? nb : tau);
      vm[dh * 3 + dw] = valid ? 1.f : 0.f;
    }
}

__device__ void phase3(const Params& p, unsigned char* smem) {
  const int tid = tid_opaque();
  u16* T = (u16*)smem;
  const int cg = tid & 15, tk0 = tid >> 4;
  constexpr int NTASK = 2 * 33 * 24;
  float* sW = (float*)(T + 6 * 66 * 128);
  u32x4 pre[12]; u32x4 preh = {0u, 0u, 0u, 0u}; float4 prew = make_float4(0.f, 0.f, 0.f, 0.f);
  auto decode = [&](int task, int& bl, int& g, int& seg, int& head) { const int sh = task % 24; g = (task / 24) % 33; bl = task / (24 * 33); seg = sh >> 3; head = sh & 7; };
  auto issue = [&](int task) {
    int bl, g, seg, head; decode(task, bl, g, seg, head);
    const u16* base = WS_YB(p) + (size_t)bl * TOK * 3072 + seg * 1024 + head * 128;
#pragma unroll
    for (int j = 0; j < 12; ++j) {
      const int piece = tid + 512 * j, dh = piece >> 10, c = (piece >> 4) & 63, ch = piece & 15;
      const int m = 4 * g + dh - 1;
      const bool valid = (g == 0) ? (m >= 0 && m < 4) : (m >= 4 && m < 132);
      pre[j] = (u32x4){0u, 0u, 0u, 0u};
      if (valid) pre[j] = *(const u32x4*)(base + (size_t)(64 * m + c) * 3072 + ch * 8);
    }
    if (tid < 288) prew = *(const float4*)(p.conv_w + (tid >> 5) * 3072 + seg * 1024 + head * 128 + (tid & 31) * 4);
    preh = (u32x4){0u, 0u, 0u, 0u};
    if (tid < 128 && g == 0) {
      const int row = tid >> 5, side = (tid >> 4) & 1, tok = side ? 64 * row + 64 : 64 * row - 1;
      if (tok >= 0 && tok < CTXL) preh = *(const u32x4*)(base + (size_t)tok * 3072 + (tid & 15) * 8);
    }
  };
  auto stage = [&]() {
#pragma unroll
    for (int j = 0; j < 12; ++j) { const int piece = tid + 512 * j, dh = piece >> 10, c = (piece >> 4) & 63, ch = piece & 15; *(u32x4*)(T + ((dh * 66 + c + 1) * 128 + ch * 8)) = pre[j]; }
    if (tid < 288) *(float4*)(sW + (tid >> 5) * 128 + (tid & 31) * 4) = prew;
    if (tid < 128) {
      const int row = tid >> 5, side = (tid >> 4) & 1, ch = tid & 15;
      *(u32x4*)(T + (((row + 1) * 66 + side * 65) * 128 + ch * 8)) = preh;
    } else if (tid < 192) {
      const int u = tid - 128, dh = (u >> 5) * 5, side = (u >> 4) & 1, ch = u & 15;
      *(u32x4*)(T + ((dh * 66 + side * 65) * 128 + ch * 8)) = (u32x4){0u, 0u, 0u, 0u};
    }
  };
  int task = bid_opaque();
  if (task < NTASK) issue(task);
  for (; task < NTASK; task += gridDim.x) {
    int bl, g, seg, head; decode(task, bl, g, seg, head);
    __syncthreads();
    stage();
    float w[9][8];
    const float rowm = g == 0 ? 0.f : 1.f;
    __syncthreads();
#pragma unroll
    for (int t = 0; t < 9; ++t) {
      const float* wp = sW + t * 128 + cg * 8;
      const float4 a = *(const float4*)wp, b = *(const float4*)(wp + 4);
      const float m = (t >= 3 && t < 6) ? 1.f : rowm;
      w[t][0] = a.x * m; w[t][1] = a.y * m; w[t][2] = a.z * m; w[t][3] = a.w * m; w[t][4] = b.x * m; w[t][5] = b.y * m; w[t][6] = b.z * m; w[t][7] = b.w * m;
    }
    if (task + (int)gridDim.x < NTASK) issue(task + gridDim.x);
#pragma unroll 2
    for (int kk = 0; kk < 8; ++kk) {
      const int row = kk >> 1, t = tk0 + 32 * (kk & 1);
      float acc[8];
#pragma unroll
      for (int e = 0; e < 8; ++e) acc[e] = 0.f;
#pragma unroll
      for (int dh = 0; dh < 3; ++dh)
#pragma unroll
        for (int dw = 0; dw < 3; ++dw) {
          const u32x4 q = *(const u32x4*)(T + (((row + dh) * 66 + t + dw) * 128 + cg * 8));
#pragma unroll
          for (int e = 0; e < 4; ++e) { acc[2 * e] += w[dh * 3 + dw][2 * e] * bf2f(q[e] & 0xFFFFu); acc[2 * e + 1] += w[dh * 3 + dw][2 * e + 1] * bf2f(q[e] >> 16); }
        }
      float ss = 0.f;
#pragma unroll
      for (int e = 0; e < 8; ++e) { acc[e] = siluf_(acc[e]); ss += acc[e] * acc[e]; }
      ss += __shfl_xor(ss, 1, 64); ss += __shfl_xor(ss, 2, 64); ss += __shfl_xor(ss, 4, 64); ss += __shfl_xor(ss, 8, 64);
      const float sc = seg == 2 ? 1.f : rsqrtf(ss + 1e-6f) * (seg == 0 ? 0.08838834764831845f : 1.f);
      u32x4 o;
#pragma unroll
      for (int e = 0; e < 4; ++e) o[e] = pk2bf(acc[2 * e] * sc, acc[2 * e + 1] * sc);
      *(u32x4*)(WS_QKVB(p) + (size_t)(bl * TOK + 64 * (4 * g + row) + t) * 3072 + seg * 1024 + head * 128 + cg * 8) = o;
    }
  }
  __syncthreads();
}

__device__ __forceinline__ int scan_tau(int dir, int i) { return dir == 0 ? i : (i < CTXL ? (CTXL - 1 - i) : (TOK + CTXL - 1 - i)); }

__device__ void scan_hgrn(const Params& p, int task, unsigned char* smem) {
  const int tid = tid_opaque();
  const int dir = task & 1, h = (task >> 1) & 7, bl = task >> 4;
  float* sq = (float*)smem;
  float* sf = sq + 16 * 144;
  float* sk = sf + 16 * 144;
  float* sv = sk + 16 * 144;
  const int v = tid >> 2, kg = tid & 3;
  float S[32];
#pragma unroll
  for (int j = 0; j < 32; ++j) S[j] = 0.f;
  u16* O = (u16*)WS_H(p) + (size_t)(0 * 2 + dir) * MPL * 1024;
  for (int i0 = 0; i0 < TOK; i0 += 16) {
    __syncthreads();
    {
      const int ti = tid >> 5, ch4 = (tid & 31) * 4;
      const int tau = scan_tau(dir, i0 + ti);
      const u16* rowp = WS_YA(p) + (size_t)(bl * TOK + tau) * 4096 + h * 128 + ch4;
      const uint2 qv = *(const uint2*)(rowp), gv = *(const uint2*)(rowp + 1024 + dir * 1024), vv = *(const uint2*)(rowp + 3072);
      const int o = ti * 144 + (ch4 >> 5) * 36 + (ch4 & 31);
      const float g0 = __expf(h2f(gv.x & 0xFFFFu)), g1 = __expf(h2f(gv.x >> 16)), g2 = __expf(h2f(gv.y & 0xFFFFu)), g3 = __expf(h2f(gv.y >> 16));
      sq[o] = bf2f(qv.x & 0xFFFFu); sq[o + 1] = bf2f(qv.x >> 16); sq[o + 2] = bf2f(qv.y & 0xFFFFu); sq[o + 3] = bf2f(qv.y >> 16);
      sf[o] = g0; sf[o + 1] = g1; sf[o + 2] = g2; sf[o + 3] = g3;
      sk[o] = 1.f - g0; sk[o + 1] = 1.f - g1; sk[o + 2] = 1.f - g2; sk[o + 3] = 1.f - g3;
      float* dv = sv + ti * 128 + ch4;
      dv[0] = bf2f(vv.x & 0xFFFFu); dv[1] = bf2f(vv.x >> 16); dv[2] = bf2f(vv.y & 0xFFFFu); dv[3] = bf2f(vv.y >> 16);
    }
    __syncthreads();
    for (int ti = 0; ti < 16; ++ti) {
      const int tau = scan_tau(dir, i0 + ti);
      const float vv = sv[ti * 128 + v];
      const float4* q4 = (const float4*)(sq + ti * 144 + kg * 36);
      const float4* f4 = (const float4*)(sf + ti * 144 + kg * 36);
      const float4* k4 = (const float4*)(sk + ti * 144 + kg * 36);
      float acc = 0.f;
#pragma unroll
      for (int j = 0; j < 8; ++j) {
        const float4 q = q4[j], f = f4[j], k = k4[j];
        S[4 * j + 0] = f.x * S[4 * j + 0] + k.x * vv; acc += q.x * S[4 * j + 0];
        S[4 * j + 1] = f.y * S[4 * j + 1] + k.y * vv; acc += q.y * S[4 * j + 1];
        S[4 * j + 2] = f.z * S[4 * j + 2] + k.z * vv; acc += q.z * S[4 * j + 2];
        S[4 * j + 3] = f.w * S[4 * j + 3] + k.w * vv; acc += q.w * S[4 * j + 3];
      }
      acc += __shfl_xor(acc, 1, 64); acc += __shfl_xor(acc, 2, 64);
      if (kg == 0 && tau >= CTXL) O[(size_t)(bl * SEQ + tau - CTXL) * 1024 + h * 128 + v] = (u16)f2bf(acc);
    }
  }
}

__device__ void scan_gdn(const Params& p, int task, unsigned char* smem) {
  const int tid = tid_opaque();
  const int vh = task & 1, dir = (task >> 1) & 1, h = (task >> 2) & 7, bl = task >> 5;
  float* sq = (float*)smem;
  float* sk = sq + 16 * 160;
  float* sv = sk + 16 * 160;
  float* sa = sv + 16 * 64;
  float* sb = sa + 16;
  const int v = tid >> 3, kg = tid & 7;
  float S[16];
#pragma unroll
  for (int j = 0; j < 16; ++j) S[j] = 0.f;
  u16* O = (u16*)WS_H(p) + (size_t)(1 * 2 + dir) * MPL * 1024;
  for (int i0 = 0; i0 < TOK; i0 += 16) {
    __syncthreads();
    {
      const int ti = tid >> 5, ch4 = (tid & 31) * 4;
      const int tau = scan_tau(dir, i0 + ti);
      const size_t row = (size_t)(bl * TOK + tau);
      const u16* rowp = WS_QKVB(p) + row * 3072 + h * 128;
      const uint2 qv = *(const uint2*)(rowp + ch4), kv = *(const uint2*)(rowp + 1024 + ch4);
      const u32 vv = *(const u32*)(rowp + 2048 + vh * 64 + (tid & 31) * 2);
      const int o = ti * 160 + (ch4 >> 4) * 20 + (ch4 & 15);
      sq[o] = bf2f(qv.x & 0xFFFFu); sq[o + 1] = bf2f(qv.x >> 16); sq[o + 2] = bf2f(qv.y & 0xFFFFu); sq[o + 3] = bf2f(qv.y >> 16);
      sk[o] = bf2f(kv.x & 0xFFFFu); sk[o + 1] = bf2f(kv.x >> 16); sk[o + 2] = bf2f(kv.y & 0xFFFFu); sk[o + 3] = bf2f(kv.y >> 16);
      sv[ti * 64 + (tid & 31) * 2] = bf2f(vv & 0xFFFFu); sv[ti * 64 + (tid & 31) * 2 + 1] = bf2f(vv >> 16);
      if (tid < 16) {
        const size_t row2 = (size_t)(bl * TOK + scan_tau(dir, i0 + tid));
        sa[tid] = __expf(WS_AB(p)[row2 * 32 + dir * 8 + h]); sb[tid] = WS_AB(p)[row2 * 32 + 16 + dir * 8 + h];
      }
    }
    __syncthreads();
    for (int ti = 0; ti < 16; ++ti) {
      const int tau = scan_tau(dir, i0 + ti);
      const float vv = sv[ti * 64 + v], a = sa[ti], be = sb[ti];
      const float4* q4 = (const float4*)(sq + ti * 160 + kg * 20);
      const float4* k4 = (const float4*)(sk + ti * 160 + kg * 20);
      float4 kk[4];
      float u = 0.f;
#pragma unroll
      for (int j = 0; j < 4; ++j) { kk[j] = k4[j]; u += kk[j].x * S[4 * j] + kk[j].y * S[4 * j + 1] + kk[j].z * S[4 * j + 2] + kk[j].w * S[4 * j + 3]; }
      u += __shfl_xor(u, 1, 64); u += __shfl_xor(u, 2, 64); u += __shfl_xor(u, 4, 64);
      const float wv = be * (vv - a * u);
      float acc = 0.f;
#pragma unroll
      for (int j = 0; j < 4; ++j) {
        const float4 q = q4[j];
        S[4 * j + 0] = a * S[4 * j + 0] + kk[j].x * wv; acc += q.x * S[4 * j + 0];
        S[4 * j + 1] = a * S[4 * j + 1] + kk[j].y * wv; acc += q.y * S[4 * j + 1];
        S[4 * j + 2] = a * S[4 * j + 2] + kk[j].z * wv; acc += q.z * S[4 * j + 2];
        S[4 * j + 3] = a * S[4 * j + 3] + kk[j].w * wv; acc += q.w * S[4 * j + 3];
      }
      acc += __shfl_xor(acc, 1, 64); acc += __shfl_xor(acc, 2, 64); acc += __shfl_xor(acc, 4, 64);
      if (kg == 0 && tau >= CTXL) O[(size_t)(bl * SEQ + tau - CTXL) * 1024 + h * 128 + vh * 64 + v] = (u16)f2bf(acc);
    }
  }
}


typedef float f32x16 __attribute__((ext_vector_type(16)));
typedef short s16x4 __attribute__((ext_vector_type(4)));
#define MFMA32(a, b, c) __builtin_amdgcn_mfma_f32_32x32x16_bf16((a), (b), (c), 0, 0, 0)
__device__ __forceinline__ int crow(int reg, int h) { return (reg & 3) + 8 * (reg >> 2) + 4 * h; }
__device__ __forceinline__ bf16x8 pack8(const f32x16& x, int s) {
  u32x4 w; w.x = pk2bf(x[8 * s + 0], x[8 * s + 1]); w.y = pk2bf(x[8 * s + 2], x[8 * s + 3]); w.z = pk2bf(x[8 * s + 4], x[8 * s + 5]); w.w = pk2bf(x[8 * s + 6], x[8 * s + 7]);
  return __builtin_bit_cast(bf16x8, w);
}
__device__ __forceinline__ bf16x8 cat4(s16x4 lo, s16x4 hi) { return __builtin_shufflevector(lo, hi, 0, 1, 2, 3, 4, 5, 6, 7); }
__device__ __forceinline__ bf16x8 ld_perm(const u16* p, int h) { return cat4(*(const s16x4*)(p + 4 * h), *(const s16x4*)(p + 8 + 4 * h)); }
__device__ __forceinline__ s16x4 tr_rd(const u16* p) { return __builtin_amdgcn_ds_read_tr16_b64_v4i16((__attribute__((address_space(3))) s16x4*)p); }

template <int DIR> __device__ __forceinline__ void gdn_prep_task(const Params& p, int pass, float* An, int tk, int lane) {
  const int r = lane & 31, h2 = lane >> 5;
  const int n = tk % 132, bh = tk / 132, hh = bh & 7, bl = bh >> 3;
  const size_t r0 = (size_t)bl * TOK + (size_t)n * 64;
  const u16* qb = WS_QKVB(p) + r0 * 3072 + hh * 128;
  const u16* kb = qb + 1024;
  const float g = WS_AB(p)[(r0 + lane) * 32 + DIR * 8 + hh], be = WS_AB(p)[(r0 + lane) * 32 + 16 + DIR * 8 + hh];
  bf16x8 kf[8][2], qf[8][2];
  {
    const u16* krow_ = kb + (size_t)r * 3072 + 8 * h2;
    const u16* qrow_ = qb + (size_t)r * 3072 + 8 * h2;
#pragma unroll
    for (int s = 0; s < 8; ++s)
#pragma unroll
      for (int rt = 0; rt < 2; ++rt) kf[s][rt] = *(const bf16x8*)(krow_ + (size_t)rt * 32 * 3072 + 16 * s);
#pragma unroll
    for (int s = 0; s < 8; ++s)
#pragma unroll
      for (int rt = 0; rt < 2; ++rt) qf[s][rt] = *(const bf16x8*)(qrow_ + (size_t)rt * 32 * 3072 + 16 * s);
  }
  An[lane] = g;
  asm volatile("" ::: "memory");
  float b = 0.f, blast = 0.f;
#pragma unroll
  for (int j4 = 0; j4 < 16; ++j4) {
    const float4 gv = *(const float4*)(An + 4 * j4);
    blast += (gv.x + gv.y) + (gv.z + gv.w);
    const int j = 4 * j4;
    if (DIR == 0) { b += (j <= lane ? gv.x : 0.f) + (j + 1 <= lane ? gv.y : 0.f) + (j + 2 <= lane ? gv.z : 0.f) + (j + 3 <= lane ? gv.w : 0.f); }
    else { b += (j >= lane ? gv.x : 0.f) + (j + 1 >= lane ? gv.y : 0.f) + (j + 2 >= lane ? gv.z : 0.f) + (j + 3 >= lane ? gv.w : 0.f); }
  }
  asm volatile("" ::: "memory");
  float* gs = WS_GS(p) + (size_t)(tk * 2 + DIR) * 256;
  gs[lane] = __expf(b); gs[64 + lane] = __expf(blast - b); gs[128 + lane] = be; if (lane == 0) gs[192] = __expf(blast);
  u16* pout = (DIR ? (u16*)(p.out + (size_t)pass * MPL * 1024) : WS_PPf(p)) + (size_t)tk * 4096;
#pragma unroll
  for (int i = 0; i < 16; ++i) *(float4*)(An + (i * 64 + lane) * 4) = make_float4(0.f, 0.f, 0.f, 0.f);
  asm volatile("" ::: "memory");
  An[lane] = b;
  asm volatile("" ::: "memory");
  const float bs0 = An[r], bs1 = An[32 + r];
  asm volatile("" ::: "memory");
#pragma unroll
  for (int which = 0; which < 2; ++which) {
    f32x16 kk[2][2];
#pragma unroll
    for (int a = 0; a < 2; ++a)
#pragma unroll
      for (int c = 0; c < 2; ++c)
#pragma unroll
        for (int i = 0; i < 16; ++i) kk[a][c][i] = 0.f;
    asm volatile("" ::: "memory");
    An[lane] = which ? b : b + __logf(be);
    asm volatile("" ::: "memory");
#pragma unroll
    for (int s = 0; s < 8; ++s)
#pragma unroll
      for (int rt = 0; rt < 2; ++rt)
#pragma unroll
        for (int ct = 0; ct < 2; ++ct) kk[rt][ct] = MFMA32(which ? qf[s][rt] : kf[s][rt], kf[s][ct], kk[rt][ct]);
    const int lpart = 4 * h2 * 64 + r;
    u16* pb = pout + lpart;
    float* ab0 = DIR ? (An + 4095 - lpart) : (An + lpart);
    const float* brow = An + 4 * h2;
    int r_o = r, h4_o = 4 * h2;
    asm volatile("" : "+v"(pb), "+v"(ab0), "+v"(brow), "+v"(r_o), "+v"(h4_o));
#pragma unroll
    for (int rt = 0; rt < 2; ++rt)
#pragma unroll
      for (int i = 0; i < 16; ++i) {
        const int tc = rt * 32 + (i & 3) + 8 * (i >> 2);
        const int t = tc + h4_o;
        const float bt = brow[tc];
#pragma unroll
        for (int ct = 0; ct < 2; ++ct) {
          const int sidx = ct * 32 + r_o;
          const bool strict = DIR ? (sidx > t) : (sidx < t);
          const bool incl = strict || (sidx == t);
          const float dec = incl ? __expf(bt - (ct ? bs1 : bs0)) : 0.f;
          if (which == 0) { if (strict) { if (DIR) ab0[-(tc * 64 + ct * 32)] = kk[rt][ct][i] * dec; else ab0[tc * 64 + ct * 32] = kk[rt][ct][i] * dec; } }
          else pb[tc * 64 + ct * 32] = (u16)f2bf(kk[rt][ct][i] * dec);
        }
      }
    asm volatile("" ::: "memory");
  }
  float x[64];
#pragma unroll
  for (int i = 0; i < 64; ++i) x[i] = 0.f;
  int lane_s = lane;
  float4 ra[2][16];
#pragma unroll
  for (int i = 0; i < 64; ++i) {
    if (i + 1 < 64) {
#pragma unroll
      for (int j4 = 0; j4 < (i + 1 + 3) / 4; ++j4) ra[(i + 1) & 1][j4] = *(const float4*)(An + (i + 1) * 64 + 4 * j4);
    }
    __builtin_amdgcn_sched_barrier(0);
    asm volatile("" : "+v"(lane_s));
    float acc = (i == lane_s) ? 1.f : 0.f;
#pragma unroll
    for (int j4 = 0; j4 < (i + 3) / 4; ++j4) {
      const float4 a = ra[i & 1][j4];
      acc -= a.x * x[4 * j4 + 0]; acc -= a.y * x[4 * j4 + 1]; acc -= a.z * x[4 * j4 + 2]; acc -= a.w * x[4 * j4 + 3];
    }
    asm volatile("" : "+v"(acc));
    x[i] = acc;
    __builtin_amdgcn_sched_barrier(0);
  }
  u16* tout = (DIR ? WS_TPb(p) : WS_TPf(p)) + (size_t)tk * 4096;
  u16* tcol = tout + (DIR ? (63 * 64 + 63 - lane_s) : lane_s);
  asm volatile("" : "+v"(tcol));
#pragma unroll
  for (int i = 0; i < 64; ++i) { if (DIR) tcol[-(i * 64)] = (u16)f2bf(x[i]); else tcol[i * 64] = (u16)f2bf(x[i]); }
  asm volatile("" ::: "memory");
}

__device__ void gdn_prep(const Params& p, int pass, unsigned char* smem) {
  const int tid = tid_opaque(), wv = tid >> 6;
  float* An = (float*)smem + wv * 4096;
  const int gw = bid_opaque() * 8 + wv, nw = gridDim.x * 8;
#ifdef PROBE_GPREP2
  for (int rep = 0; rep < 2; ++rep)
#endif
  for (int wt = gw; wt < 2112 * 2; wt += nw) {
    int lane = tid & 63; asm volatile("" : "+v"(lane));
    if (wt & 1) gdn_prep_task<1>(p, pass, An, wt >> 1, lane); else gdn_prep_task<0>(p, pass, An, wt >> 1, lane);
  }
}

#define SEQ_BAR() do { asm volatile("s_waitcnt lgkmcnt(0)" ::: "memory"); __builtin_amdgcn_s_barrier(); asm volatile("" ::: "memory"); } while (0)
__device__ __forceinline__ int gdn_chunk_of(int dir, int i) { return dir == 0 ? i : (i < 4 ? 3 - i : 135 - i); }

__device__ void gdn_seq(const Params& p, int pass, int chain, int vh, unsigned char* smem, int dry) {
  const int tid = tid_opaque(), lane = tid & 63, wv = tid >> 6, r = lane & 31, h2 = lane >> 5;
  const int dir = chain & 1, hh = (chain >> 1) & 7, bl = chain >> 4;
  constexpr int RS = 136, RT = 72;
  constexpr int BUF = 3 * 64 * RS + 2 * 64 * RT + 512;
  const u16* PPb = (const u16*)(p.out + (size_t)pass * MPL * 1024);
  const u16* Tg = dir ? WS_TPb(p) : WS_TPf(p); const u16* Pg = dir ? PPb : WS_PPf(p);
  u16* O = (u16*)WS_H(p) + (size_t)(2 + dir) * MPL * 1024;
  const int v0 = vh * 32;
  const bool isO = wv == 1;
  u32x4* XV = (u32x4*)((u16*)smem + 2 * BUF) + lane;
  const int tq = (lane & 15) >> 2, tp = lane & 3, blk = (lane >> 4) & 1;
  const int zro = dir ? 1 : 0, zrt = dir ? 0 : 1;
  if (wv >= 4) {
    const int lt = tid - 256;
    u32x4 preA[13], preB[13]; float pregA = 0.f, pregB = 0.f;
    auto issue = [&](int n, u32x4 (&pre)[13], float& preg) {
      const int tk = (bl * 8 + hh) * 132 + n;
      const size_t r0 = (size_t)bl * TOK + (size_t)n * 64;
      const u16* base = WS_QKVB(p) + r0 * 3072 + hh * 128;
#pragma unroll
      for (int j = 0; j < 8; ++j) { const int piece = lt + 256 * (j & 3), row = piece >> 4, ch = piece & 15; pre[j] = *(const u32x4*)(base + (size_t)row * 3072 + (j >> 2) * 1024 + ch * 8); }
      pre[8] = *(const u32x4*)(base + (size_t)(lt >> 2) * 3072 + 2048 + (vh * 4 + (lt & 3)) * 8);
#pragma unroll
      for (int j = 0; j < 2; ++j) { pre[9 + j] = *(const u32x4*)(Tg + (size_t)tk * 4096 + (lt + 256 * j) * 8); pre[11 + j] = *(const u32x4*)(Pg + (size_t)tk * 4096 + (lt + 256 * j) * 8); }
      if (lt < 193) preg = WS_GS(p)[(size_t)(tk * 2 + dir) * 256 + lt];
    };
    auto stage = [&](int b, const u32x4 (&pre)[13], float preg) {
      u16* sQ = (u16*)smem + b * BUF; u16* sT = sQ + 3 * 64 * RS; u16* sP = sT + 64 * RT; float* sG = (float*)(sP + 64 * RT);
#pragma unroll
      for (int j = 0; j < 8; ++j) { const int piece = lt + 256 * (j & 3), row = piece >> 4, ch = piece & 15; *(u32x4*)(sQ + (j >> 2) * 64 * RS + row * RS + ch * 8) = pre[j]; }
      *(u32x4*)(sQ + 2 * 64 * RS + (lt >> 2) * RS + (vh * 4 + (lt & 3)) * 8) = pre[8];
#pragma unroll
      for (int j = 0; j < 2; ++j) { const int piece = lt + 256 * j, row = piece >> 3, ch = piece & 7; *(u32x4*)(sT + row * RT + ch * 8) = pre[9 + j]; *(u32x4*)(sP + row * RT + ch * 8) = pre[11 + j]; }
      if (lt < 193) sG[lt] = preg;
    };
    const u16* OTl = (const u16*)smem + 2 * BUF + 2048;
    auto flushO = [&](int itp) {
      const int np = gdn_chunk_of(dir, itp);
      if (np >= 4 && !dry) {
        const int row = lt >> 2, pc = lt & 3;
        const u32x4 v = *(const u32x4*)(OTl + (itp & 1) * 2560 + row * 40 + pc * 8);
        *(u32x4*)(O + ((size_t)bl * SEQ + (size_t)(np - 4) * 64 + row) * 1024 + hh * 128 + vh * 32 + pc * 8) = v;
      }
    };
    issue(gdn_chunk_of(dir, 0), preA, pregA);
    stage(0, preA, pregA);
    issue(gdn_chunk_of(dir, 1), preA, pregA);
    issue(gdn_chunk_of(dir, 2), preB, pregB);
    SEQ_BAR();
    for (int it = 0; it < 132; it += 2) {
      if (it > 0) flushO(it - 1);
      stage((it + 1) & 1, preA, pregA);
      if (it + 3 < 132) issue(gdn_chunk_of(dir, it + 3), preA, pregA);
      SEQ_BAR();
      SEQ_BAR();
      flushO(it);
      if (it + 2 < 132) stage((it + 2) & 1, preB, pregB);
      if (it + 4 < 132) issue(gdn_chunk_of(dir, it + 4), preB, pregB);
      SEQ_BAR();
      SEQ_BAR();
    }
    flushO(131);
    return;
  }
  if (wv >= 2) { SEQ_BAR(); for (int it = 0; it < 132; ++it) { SEQ_BAR(); SEQ_BAR(); } return; }
  f32x16 S[4];
#pragma unroll
  for (int kt = 0; kt < 4; ++kt)
#pragma unroll
    for (int i = 0; i < 16; ++i) S[kt][i] = 0.f;
  SEQ_BAR();
#define SB_() __builtin_amdgcn_sched_barrier(0)
  if (!isO) {
  for (int it = 0; it < 132; ++it) {
    const int n = gdn_chunk_of(dir, it);
    const u16* sQ = (const u16*)smem + (it & 1) * BUF; const u16* sK = sQ + 64 * RS; const u16* sV = sK + 64 * RS; const u16* sT = sV + 64 * RS; const u16* sP = sT + 64 * RT;
    const float* sG = (const float*)(sP + 64 * RT);
    const int offA = r * RS;
    bf16x8 Vbs[2][2];
      f32x16 X[2];
#pragma unroll
      for (int rt = 0; rt < 2; ++rt)
#pragma unroll
        for (int i = 0; i < 16; ++i) X[rt][i] = 0.f;
      bf16x8 fk[2][4];
#define LDG_(kt, b) do { _Pragma("unroll") for (int rt = 0; rt < 2; ++rt) _Pragma("unroll") for (int s2 = 0; s2 < 2; ++s2) \
        fk[b][rt * 2 + s2] = ld_perm(sK + offA + 32 * rt * RS + 32 * (kt) + 16 * s2, h2); } while (0)
      LDG_(0, 0);
#pragma unroll
      for (int kt = 0; kt < 4; ++kt) {
        SB_();
        if (kt < 3) LDG_(kt + 1, (kt + 1) & 1);
        const bf16x8 sb0 = pack8(S[kt], 0), sb1 = pack8(S[kt], 1);
        SB_();
        X[0] = MFMA32(fk[kt & 1][0], sb0, X[0]); X[1] = MFMA32(fk[kt & 1][2], sb0, X[1]);
        X[0] = MFMA32(fk[kt & 1][1], sb1, X[0]); X[1] = MFMA32(fk[kt & 1][3], sb1, X[1]);
      }
#undef LDG_
      SB_();
      bf16x8 ft[3][2];
#pragma unroll
      for (int s2 = 0; s2 < 2; ++s2) {
        ft[0][s2] = ld_perm(sT + (r) * RT + 16 * s2, h2);
        ft[1][s2] = ld_perm(sT + (32 + r) * RT + 32 + 16 * s2, h2);
        ft[2][s2] = ld_perm(sT + (32 * zrt + r) * RT + 32 * zro + 16 * s2, h2);
      }
#pragma unroll
      for (int rt = 0; rt < 2; ++rt) {
        float vv[16]; float4 eb4[4], be4[4];
        const int tb = 32 * rt + 4 * h2;
#pragma unroll
        for (int g = 0; g < 4; ++g) { eb4[g] = *(const float4*)(sG + tb + 8 * g); be4[g] = *(const float4*)(sG + 128 + tb + 8 * g); }
#pragma unroll
        for (int i = 0; i < 16; ++i) vv[i] = bf2f(sV[(tb + (i & 3) + 8 * (i >> 2)) * RS + v0 + r]);
        SB_();
#pragma unroll
        for (int g = 0; g < 4; ++g) {
          X[rt][4 * g + 0] = be4[g].x * (vv[4 * g + 0] - eb4[g].x * X[rt][4 * g + 0]);
          X[rt][4 * g + 1] = be4[g].y * (vv[4 * g + 1] - eb4[g].y * X[rt][4 * g + 1]);
          X[rt][4 * g + 2] = be4[g].z * (vv[4 * g + 2] - eb4[g].z * X[rt][4 * g + 2]);
          X[rt][4 * g + 3] = be4[g].w * (vv[4 * g + 3] - eb4[g].w * X[rt][4 * g + 3]);
        }
        SB_();
      }
      bf16x8 Yb[2][2];
#pragma unroll
      for (int rt = 0; rt < 2; ++rt) { Yb[rt][0] = pack8(X[rt], 0); Yb[rt][1] = pack8(X[rt], 1); }
      f32x16 VN[2];
#pragma unroll
      for (int ro = 0; ro < 2; ++ro)
#pragma unroll
        for (int i = 0; i < 16; ++i) VN[ro][i] = 0.f;
      VN[0] = MFMA32(ft[0][0], Yb[0][0], VN[0]); VN[1] = MFMA32(ft[1][0], Yb[1][0], VN[1]);
      VN[0] = MFMA32(ft[0][1], Yb[0][1], VN[0]); VN[1] = MFMA32(ft[1][1], Yb[1][1], VN[1]);
      if (dir == 0) { VN[1] = MFMA32(ft[2][0], Yb[0][0], VN[1]); VN[1] = MFMA32(ft[2][1], Yb[0][1], VN[1]); }
      else { VN[0] = MFMA32(ft[2][0], Yb[1][0], VN[0]); VN[0] = MFMA32(ft[2][1], Yb[1][1], VN[0]); }
#pragma unroll
      for (int rt = 0; rt < 2; ++rt)
#pragma unroll
        for (int s2 = 0; s2 < 2; ++s2) XV[(rt * 2 + s2) * 64] = __builtin_bit_cast(u32x4, pack8(VN[rt], s2));
      SEQ_BAR();
#pragma unroll
      for (int rt = 0; rt < 2; ++rt)
#pragma unroll
        for (int g = 0; g < 4; ++g) {
          const float4 el4 = *(const float4*)(sG + 64 + 32 * rt + 8 * g + 4 * h2);
          VN[rt][4 * g + 0] *= el4.x; VN[rt][4 * g + 1] *= el4.y; VN[rt][4 * g + 2] *= el4.z; VN[rt][4 * g + 3] *= el4.w;
        }
#pragma unroll
      for (int rt = 0; rt < 2; ++rt) { Vbs[rt][0] = pack8(VN[rt], 0); Vbs[rt][1] = pack8(VN[rt], 1); }
    {
      const float el = sG[192];
      bf16x8 fa[2][4];
#define LDT_(kt, b) do { _Pragma("unroll") for (int rt = 0; rt < 2; ++rt) _Pragma("unroll") for (int s2 = 0; s2 < 2; ++s2) { \
        const u16* a0 = sK + (32 * rt + 16 * s2 + 4 * h2 + tq) * RS + 32 * (kt) + 16 * blk + 4 * tp; fa[b][rt * 2 + s2] = cat4(tr_rd(a0), tr_rd(a0 + 8 * RS)); } } while (0)
      LDT_(0, 0);
#pragma unroll
      for (int kt = 0; kt < 4; ++kt) {
        SB_();
        if (kt < 3) LDT_(kt + 1, (kt + 1) & 1);
#pragma unroll
        for (int i = 0; i < 16; ++i) S[kt][i] *= el;
        SB_();
        S[kt] = MFMA32(fa[kt & 1][0], Vbs[0][0], S[kt]); S[kt] = MFMA32(fa[kt & 1][1], Vbs[0][1], S[kt]);
        S[kt] = MFMA32(fa[kt & 1][2], Vbs[1][0], S[kt]); S[kt] = MFMA32(fa[kt & 1][3], Vbs[1][1], S[kt]);
      }
#undef LDT_
    }
    SEQ_BAR();
  }
  } else {
  for (int it = 0; it < 132; ++it) {
    const int n = gdn_chunk_of(dir, it);
    const u16* sQ = (const u16*)smem + (it & 1) * BUF; const u16* sK = sQ + 64 * RS; const u16* sV = sK + 64 * RS; const u16* sT = sV + 64 * RS; const u16* sP = sT + 64 * RT;
    const float* sG = (const float*)(sP + 64 * RT);
    const int offA = r * RS;
    bf16x8 Vbs[2][2];
      f32x16 QS[2];
#pragma unroll
      for (int rt = 0; rt < 2; ++rt)
#pragma unroll
        for (int i = 0; i < 16; ++i) QS[rt][i] = 0.f;
      bf16x8 fq[2][4];
#define LDG_(kt, b) do { _Pragma("unroll") for (int rt = 0; rt < 2; ++rt) _Pragma("unroll") for (int s2 = 0; s2 < 2; ++s2) \
        fq[b][rt * 2 + s2] = ld_perm(sQ + offA + 32 * rt * RS + 32 * (kt) + 16 * s2, h2); } while (0)
      LDG_(0, 0);
#pragma unroll
      for (int kt = 0; kt < 4; ++kt) {
        SB_();
        if (kt < 3) LDG_(kt + 1, (kt + 1) & 1);
        const bf16x8 sb0 = pack8(S[kt], 0), sb1 = pack8(S[kt], 1);
        SB_();
        QS[0] = MFMA32(fq[kt & 1][0], sb0, QS[0]); QS[1] = MFMA32(fq[kt & 1][2], sb0, QS[1]);
        QS[0] = MFMA32(fq[kt & 1][1], sb1, QS[0]); QS[1] = MFMA32(fq[kt & 1][3], sb1, QS[1]);
      }
#undef LDG_
      SB_();
      bf16x8 fp[3][2];
#pragma unroll
      for (int s2 = 0; s2 < 2; ++s2) {
        fp[0][s2] = ld_perm(sP + (r) * RT + 16 * s2, h2);
        fp[1][s2] = ld_perm(sP + (32 + r) * RT + 32 + 16 * s2, h2);
        fp[2][s2] = ld_perm(sP + (32 * zrt + r) * RT + 32 * zro + 16 * s2, h2);
      }
#pragma unroll
      for (int rt = 0; rt < 2; ++rt)
#pragma unroll
        for (int g = 0; g < 4; ++g) {
          const float4 eb4 = *(const float4*)(sG + 32 * rt + 8 * g + 4 * h2);
          QS[rt][4 * g + 0] *= eb4.x; QS[rt][4 * g + 1] *= eb4.y; QS[rt][4 * g + 2] *= eb4.z; QS[rt][4 * g + 3] *= eb4.w;
        }
      SEQ_BAR();
      u32x4 vraw[2][2];
#pragma unroll
      for (int rt = 0; rt < 2; ++rt)
#pragma unroll
        for (int s2 = 0; s2 < 2; ++s2) vraw[rt][s2] = XV[(rt * 2 + s2) * 64];
      QS[0] = MFMA32(fp[0][0], __builtin_bit_cast(bf16x8, vraw[0][0]), QS[0]); QS[1] = MFMA32(fp[1][0], __builtin_bit_cast(bf16x8, vraw[1][0]), QS[1]);
      QS[0] = MFMA32(fp[0][1], __builtin_bit_cast(bf16x8, vraw[0][1]), QS[0]); QS[1] = MFMA32(fp[1][1], __builtin_bit_cast(bf16x8, vraw[1][1]), QS[1]);
      if (dir == 0) { QS[1] = MFMA32(fp[2][0], __builtin_bit_cast(bf16x8, vraw[0][0]), QS[1]); QS[1] = MFMA32(fp[2][1], __builtin_bit_cast(bf16x8, vraw[0][1]), QS[1]); }
      else { QS[0] = MFMA32(fp[2][0], __builtin_bit_cast(bf16x8, vraw[1][0]), QS[0]); QS[0] = MFMA32(fp[2][1], __builtin_bit_cast(bf16x8, vraw[1][1]), QS[0]); }
#pragma unroll
      for (int rt = 0; rt < 2; ++rt)
#pragma unroll
        for (int s2 = 0; s2 < 2; ++s2) {
          const int t0 = 32 * rt + 16 * s2 + 4 * h2;
          const float4 ea = *(const float4*)(sG + 64 + t0), ec = *(const float4*)(sG + 64 + t0 + 8);
          const u32x4 w = vraw[rt][s2];
          u32x4 o4;
          o4.x = pk2bf(bf2f(w.x & 0xFFFFu) * ea.x, bf2f(w.x >> 16) * ea.y); o4.y = pk2bf(bf2f(w.y & 0xFFFFu) * ea.z, bf2f(w.y >> 16) * ea.w);
          o4.z = pk2bf(bf2f(w.z & 0xFFFFu) * ec.x, bf2f(w.z >> 16) * ec.y); o4.w = pk2bf(bf2f(w.w & 0xFFFFu) * ec.z, bf2f(w.w >> 16) * ec.w);
          Vbs[rt][s2] = __builtin_bit_cast(bf16x8, o4);
        }
      if (n >= 4 && !dry) {
        u16* ot = (u16*)smem + 2 * BUF + 2048 + (it & 1) * 2560 + 4 * h2 * 40 + r;
#pragma unroll
        for (int rt = 0; rt < 2; ++rt)
#pragma unroll
          for (int i = 0; i < 16; ++i) ot[(32 * rt + (i & 3) + 8 * (i >> 2)) * 40] = (u16)f2bf(QS[rt][i]);
      }

    {
      const float el = sG[192];
      bf16x8 fa[2][4];
#define LDT_(kt, b) do { _Pragma("unroll") for (int rt = 0; rt < 2; ++rt) _Pragma("unroll") for (int s2 = 0; s2 < 2; ++s2) { \
        const u16* a0 = sK + (32 * rt + 16 * s2 + 4 * h2 + tq) * RS + 32 * (kt) + 16 * blk + 4 * tp; fa[b][rt * 2 + s2] = cat4(tr_rd(a0), tr_rd(a0 + 8 * RS)); } } while (0)
      LDT_(0, 0);
#pragma unroll
      for (int kt = 0; kt < 4; ++kt) {
        SB_();
        if (kt < 3) LDT_(kt + 1, (kt + 1) & 1);
#pragma unroll
        for (int i = 0; i < 16; ++i) S[kt][i] *= el;
        SB_();
        S[kt] = MFMA32(fa[kt & 1][0], Vbs[0][0], S[kt]); S[kt] = MFMA32(fa[kt & 1][1], Vbs[0][1], S[kt]);
        S[kt] = MFMA32(fa[kt & 1][2], Vbs[1][0], S[kt]); S[kt] = MFMA32(fa[kt & 1][3], Vbs[1][1], S[kt]);
      }
#undef LDT_
    }
    SEQ_BAR();
  }
  }
#undef SB_
}

__device__ void hgrn_prep(const Params& p, int pass, unsigned char* smem, int dry) {
  const int tid = tid_opaque(), lane = tid & 63, wv = tid >> 6;
  constexpr int RSA = 136, RSS = 72;
  u16* sQs = (u16*)smem; u16* sQd = sQs + 64 * RSA; u16* sKs = sQd + 64 * RSA; u16* sKv = sKs + 64 * RSA;
  u16* sV = sKv + 48 * RSA; u16* sS = sV + 64 * RSA;
  float* sDG = (float*)(sS + 64 * RSS);
  u16* sQr = (u16*)(sDG + 512);
  u16* sGr = sQr + 64 * RSA;
  u16* QDB = (u16*)(p.out + (size_t)pass * MPL * 1024) + (size_t)2112 * 4096;
  u16* Of = (u16*)WS_H(p);
  const int k = tid & 127, I = tid >> 7;
  const int prow0 = tid >> 4, pch = tid & 15;
  u32x4 pf[6];
  auto issue_task = [&](int tkx, u32x4 (&d)[6]) {
    const int nx_ = tkx % 132, bhx = tkx / 132;
    const u16* yx = WS_YA(p) + ((size_t)(bhx >> 3) * TOK + (size_t)nx_ * 64) * 4096 + (bhx & 7) * 128;
#pragma unroll
    for (int hf = 0; hf < 2; ++hf) {
      const u16* rp = yx + (size_t)(prow0 + 32 * hf) * 4096 + pch * 8;
      d[hf] = *(const u32x4*)(rp + 3072); d[2 + hf] = *(const u32x4*)(rp); d[4 + hf] = *(const u32x4*)(rp + 1024);
    }
  };
  int tk = (int)gridDim.x - 1 - bid_opaque();
  if (tk < 2112) issue_task(tk, pf);
  for (; tk < 2112; tk += gridDim.x) {
    const int n = tk % 132, bh = tk / 132, hh = bh & 7, bl = bh >> 3;
    const size_t r0 = (size_t)bl * TOK + (size_t)n * 64;
    u16* ya = WS_YA(p) + r0 * 4096 + hh * 128;
    __syncthreads();
    *(u32x4*)(sV + prow0 * RSA + pch * 8) = pf[0]; *(u32x4*)(sV + (prow0 + 32) * RSA + pch * 8) = pf[1];
    *(u32x4*)(sQr + prow0 * RSA + pch * 8) = pf[2]; *(u32x4*)(sQr + (prow0 + 32) * RSA + pch * 8) = pf[3];
    __syncthreads();
    const u32x4 gB0 = *(const u32x4*)(ya + (size_t)prow0 * 4096 + 2048 + pch * 8), gB1 = *(const u32x4*)(ya + (size_t)(prow0 + 32) * 4096 + 2048 + pch * 8);
    u32x4 nx[6];
    if (tk + (int)gridDim.x < 2112) issue_task(tk + gridDim.x, nx);
    float qv[16];
#pragma unroll
    for (int j = 0; j < 16; ++j) qv[j] = bf2f(sQr[(16 * I + j) * RSA + k]);
#pragma unroll 1
    for (int dir = 0; dir < 2; ++dir) {
      const int P = dir ? 3 - I : I;
      u16* gt = ya + 1024 + dir * 1024;
      {
        const u32x4 g0 = dir ? gB0 : pf[4], g1 = dir ? gB1 : pf[5];
        __syncthreads();
        *(u32x4*)(sGr + prow0 * RSA + pch * 8) = g0; *(u32x4*)(sGr + (prow0 + 32) * RSA + pch * 8) = g1;
      }
      __syncthreads();
      float c[16];
#pragma unroll
      for (int j = 0; j < 16; ++j) c[j] = h2f(sGr[(16 * I + j) * RSA + k]);
      float kkv[16];
#pragma unroll
      for (int j = 0; j < 16; ++j) kkv[j] = 1.f - __expf(c[j]);
      if (dir == 0) {
#pragma unroll
        for (int j = 1; j < 16; ++j) c[j] += c[j - 1];
      } else {
#pragma unroll
        for (int j = 14; j >= 0; --j) c[j] += c[j + 1];
      }
      const float G = dir ? c[0] : c[15];
      const float DG = __expf(G), rDG = 1.f / DG;
      float Qs[16], Ks[16];
#pragma unroll
      for (int j = 0; j < 16; ++j) {
        Qs[j] = qv[j] * __expf(c[j]);
        Ks[j] = kkv[j] * __expf(G - c[j]);
        const int o = (16 * I + j) * RSA + k;
        sQs[o] = (u16)f2bf(Qs[j]); sQd[o] = (u16)f2bf(Qs[j] * rDG); sKs[o] = (u16)f2bf(Ks[j]);
      }
      sDG[P * 128 + k] = DG;
      __syncthreads();
      const float d0 = sDG[k], d1 = sDG[128 + k], d2 = sDG[256 + k], d3 = sDG[384 + k];
      const float Pfac = P == 0 ? 1.f : (P == 1 ? d0 : (P == 2 ? d0 * d1 : d0 * d1 * d2));
      const float Rfac = P == 3 ? 1.f : (P == 2 ? d3 : (P == 1 ? d2 * d3 : d1 * d2 * d3));
#pragma unroll
      for (int j = 0; j < 16; ++j) { const int o = (16 * I + j) * RSA + k; sQr[o] = (u16)f2bf(Qs[j] * Pfac); sGr[o] = (u16)f2bf(Ks[j] * Rfac); }
      if (I == 0 && !dry) WS_DL(p)[(size_t)(tk * 2 + dir) * 128 + k] = (d0 * d1) * (d2 * d3);
      if (P == 0) {
#pragma unroll
        for (int j = 0; j < 16; ++j) { sKv[j * RSA + k] = (u16)f2bf(Ks[j] * d1); sKv[(32 + j) * RSA + k] = (u16)f2bf(Ks[j] * d1 * d2); }
      } else if (P == 1) {
#pragma unroll
        for (int j = 0; j < 16; ++j) sKv[(16 + j) * RSA + k] = (u16)f2bf(Ks[j] * d2);
      }
      __syncthreads();
      if (!dry) {
        const u32x4 a0 = *(const u32x4*)(sQr + prow0 * RSA + pch * 8), a1 = *(const u32x4*)(sQr + (prow0 + 32) * RSA + pch * 8);
        const u32x4 b0 = *(const u32x4*)(sGr + prow0 * RSA + pch * 8), b1 = *(const u32x4*)(sGr + (prow0 + 32) * RSA + pch * 8);
        if (dir) { u16* qd = QDB + (size_t)tk * 8192; *(u32x4*)(qd + prow0 * 128 + pch * 8) = a0; *(u32x4*)(qd + (prow0 + 32) * 128 + pch * 8) = a1; }
        else { *(u32x4*)(ya + (size_t)prow0 * 4096 + pch * 8) = a0; *(u32x4*)(ya + (size_t)(prow0 + 32) * 4096 + pch * 8) = a1; }
        *(u32x4*)(gt + (size_t)prow0 * 4096 + pch * 8) = b0; *(u32x4*)(gt + (size_t)(prow0 + 32) * 4096 + pch * 8) = b1;
      }
      if (n >= 4) {
        const int fr = lane & 15, quad = lane >> 4;
#pragma unroll 1
        for (int blk = wv; blk < 10; blk += 8) {
          int Pt, Ps; const u16* bsrc;
          if (blk < 4) { Pt = blk; Ps = blk; }
          else if (blk < 7) { Pt = blk - 3; Ps = blk - 4; }
          else if (blk == 7) { Pt = 2; Ps = 0; }
          else if (blk == 8) { Pt = 3; Ps = 1; }
          else { Pt = 3; Ps = 0; }
          const int It = dir ? 3 - Pt : Pt, Is = dir ? 3 - Ps : Ps;
          if (blk < 7) bsrc = sKs + (16 * Is + fr) * RSA; else bsrc = sKv + (16 * (blk - 7) + fr) * RSA;
          const u16* asrc = (blk < 4 ? sQd : sQs) + (16 * It + fr) * RSA;
          f32x4 acc = {0.f, 0.f, 0.f, 0.f};
#pragma unroll
          for (int kq = 0; kq < 4; ++kq) acc = __builtin_amdgcn_mfma_f32_16x16x32_bf16(*(const bf16x8*)(asrc + 32 * kq + 8 * quad), *(const bf16x8*)(bsrc + 32 * kq + 8 * quad), acc, 0, 0, 0);
#pragma unroll
          for (int j = 0; j < 4; ++j) {
            const int tl = 4 * quad + j;
            float val = acc[j];
            u16* dst = sS + (16 * It + tl) * RSS + 16 * Is + fr;
            if (blk < 4) {
              const bool keep = dir ? (fr >= tl) : (fr <= tl);
              val = keep ? val : 0.f;
              if (dir) val += bf2f(*dst);
            }
            *dst = (u16)f2bf(val);
          }
        }
      }
      __syncthreads();
    }
    if (n >= 4) {
      const int r = lane & 31, h2 = lane >> 5, rt = wv >> 2, ct = wv & 3;
      const int tq = (lane & 15) >> 2, tp = lane & 3, blk = (lane >> 4) & 1;
      f32x16 acc;
#pragma unroll
      for (int i = 0; i < 16; ++i) acc[i] = 0.f;
#pragma unroll
      for (int s = 0; s < 4; ++s) {
        const bf16x8 a = *(const bf16x8*)(sS + (32 * rt + r) * RSS + 16 * s + 8 * h2);
        const u16* b0 = sV + (16 * s + 8 * h2 + tq) * RSA + 32 * ct + 16 * blk + 4 * tp;
        acc = MFMA32(a, cat4(tr_rd(b0), tr_rd(b0 + 4 * RSA)), acc);
      }
      u16* op = Of + ((size_t)bl * SEQ + (size_t)(n - 4) * 64 + 4 * h2) * 1024 + hh * 128 + 32 * ct + r;
      if (!dry) {
#pragma unroll
        for (int i = 0; i < 16; ++i) op[(size_t)(32 * rt + (i & 3) + 8 * (i >> 2)) * 1024] = (u16)f2bf(acc[i]);
      }
    }
#pragma unroll
    for (int j = 0; j < 6; ++j) pf[j] = nx[j];
  }
  __syncthreads();
}

__device__ void hgrn_seq(const Params& p, int pass, int chain, int vh, unsigned char* smem, int dry) {
  const int tid = tid_opaque(), lane = tid & 63, wv = tid >> 6, r = lane & 31, h2 = lane >> 5;
  const int dir = chain & 1, hh = (chain >> 1) & 7, bl = chain >> 4;
  constexpr int RS = 136;
  constexpr int BUF = 4 * 64 * RS + 256;
  const u16* QDB = (const u16*)(p.out + (size_t)pass * MPL * 1024) + (size_t)2112 * 4096;
  u16* O = (u16*)WS_H(p) + (size_t)dir * MPL * 1024;
  if (wv >= 4) {
    const int lt = tid - 256;
    u32x4 preA[10], preB[10]; float pregA = 0.f, pregB = 0.f;
    auto issue = [&](int n, u32x4 (&pre)[10], float& preg) {
      const int tk = (bl * 8 + hh) * 132 + n;
      const size_t r0 = (size_t)bl * TOK + (size_t)n * 64;
      const u16* ya = WS_YA(p) + r0 * 4096 + hh * 128;
#pragma unroll
      for (int j = 0; j < 4; ++j) {
        const int piece = lt + 256 * j, row = piece >> 4, ch = piece & 15;
        pre[j] = dir ? *(const u32x4*)(QDB + (size_t)tk * 8192 + row * 128 + ch * 8) : *(const u32x4*)(ya + (size_t)row * 4096 + ch * 8);
        pre[4 + j] = *(const u32x4*)(ya + (size_t)row * 4096 + 1024 + dir * 1024 + ch * 8);
      }
      {
        const int row = lt >> 2, ch = vh * 4 + (lt & 3);
        pre[8] = *(const u32x4*)(ya + (size_t)row * 4096 + 3072 + ch * 8);
        if (dir == 0 && n >= 4) pre[9] = *(const u32x4*)(O + ((size_t)bl * SEQ + (size_t)(n - 4) * 64 + row) * 1024 + hh * 128 + ch * 8);
      }
      if (lt < 128) preg = WS_DL(p)[(size_t)(tk * 2 + dir) * 128 + lt];
    };
    auto stage = [&](int b, const u32x4 (&pre)[10], float preg) {
      u16* sQ = (u16*)smem + b * BUF; float* sD = (float*)(sQ + 4 * 64 * RS);
#pragma unroll
      for (int j = 0; j < 4; ++j) {
        const int piece = lt + 256 * j, row = piece >> 4, ch = piece & 15;
        *(u32x4*)(sQ + row * RS + ch * 8) = pre[j]; *(u32x4*)(sQ + 64 * RS + row * RS + ch * 8) = pre[4 + j];
      }
      {
        const int row = lt >> 2, ch = vh * 4 + (lt & 3);
        *(u32x4*)(sQ + 2 * 64 * RS + row * RS + ch * 8) = pre[8];
        if (dir == 0) *(u32x4*)(sQ + 3 * 64 * RS + row * RS + ch * 8) = pre[9];
      }
      if (lt < 128) sD[lt] = preg;
    };
    const u16* OTl = (const u16*)smem + 2 * BUF;
    auto flushO = [&](int itp) {
      const int np = gdn_chunk_of(dir, itp);
      if (np >= 4 && !dry) {
        const int row = lt >> 2, pc = lt & 3;
        const u32x4 v = *(const u32x4*)(OTl + (itp & 1) * 2560 + row * 40 + pc * 8);
        *(u32x4*)(O + ((size_t)bl * SEQ + (size_t)(np - 4) * 64 + row) * 1024 + hh * 128 + vh * 32 + pc * 8) = v;
      }
    };
    issue(gdn_chunk_of(dir, 0), preA, pregA);
    stage(0, preA, pregA);
    issue(gdn_chunk_of(dir, 1), preA, pregA);
    issue(gdn_chunk_of(dir, 2), preB, pregB);
    SEQ_BAR();
    for (int it = 0; it < 132; it += 2) {
      if (it > 0) flushO(it - 1);
      stage((it + 1) & 1, preA, pregA);
      if (it + 3 < 132) issue(gdn_chunk_of(dir, it + 3), preA, pregA);
      SEQ_BAR();
      flushO(it);
      if (it + 2 < 132) stage((it + 2) & 1, preB, pregB);
      if (it + 4 < 132) issue(gdn_chunk_of(dir, it + 4), preB, pregB);
      SEQ_BAR();
    }
    flushO(131);
    return;
  }
  f32x16 S[4];
#pragma unroll
  for (int kt = 0; kt < 4; ++kt)
#pragma unroll
    for (int i = 0; i < 16; ++i) S[kt][i] = 0.f;
  if (wv >= 1) { SEQ_BAR(); for (int it = 0; it < 132; ++it) SEQ_BAR(); return; }
  const int v0 = vh * 32;
  const int tq = (lane & 15) >> 2, tp = lane & 3, blk = (lane >> 4) & 1;
  SEQ_BAR();
  for (int it = 0; it < 132; ++it) {
    const int n = gdn_chunk_of(dir, it);
    const u16* sQ = (const u16*)smem + (it & 1) * BUF; const u16* sK = sQ + 64 * RS; const u16* sV = sK + 64 * RS; const u16* sO = sV + 64 * RS;
    const float* sD = (const float*)(sO + 64 * RS);
#define SB_() __builtin_amdgcn_sched_barrier(0)
    bf16x8 vb[2][2];
#pragma unroll
    for (int rt = 0; rt < 2; ++rt)
#pragma unroll
      for (int s2 = 0; s2 < 2; ++s2) {
        const u16* b0 = sV + (32 * rt + 16 * s2 + 8 * h2 + tq) * RS + v0 + 16 * blk + 4 * tp;
        vb[rt][s2] = cat4(tr_rd(b0), tr_rd(b0 + 4 * RS));
      }
    if (n >= 4 && !dry) {
      f32x16 X[2];
#pragma unroll
      for (int rt = 0; rt < 2; ++rt)
#pragma unroll
        for (int i = 0; i < 16; ++i) X[rt][i] = 0.f;
      bf16x8 fq[2][4];
      const int offA = r * RS;
#define LDG_(kt, b) do { _Pragma("unroll") for (int rt = 0; rt < 2; ++rt) _Pragma("unroll") for (int s2 = 0; s2 < 2; ++s2) \
        fq[b][rt * 2 + s2] = ld_perm(sQ + offA + 32 * rt * RS + 32 * (kt) + 16 * s2, h2); } while (0)
      LDG_(0, 0);
#pragma unroll
      for (int kt = 0; kt < 4; ++kt) {
        SB_();
        if (kt < 3) LDG_(kt + 1, (kt + 1) & 1);
        const bf16x8 sb0 = pack8(S[kt], 0), sb1 = pack8(S[kt], 1);
        SB_();
        X[0] = MFMA32(fq[kt & 1][0], sb0, X[0]); X[1] = MFMA32(fq[kt & 1][2], sb0, X[1]);
        X[0] = MFMA32(fq[kt & 1][1], sb1, X[0]); X[1] = MFMA32(fq[kt & 1][3], sb1, X[1]);
      }
#undef LDG_
      SB_();
      u16* op = (u16*)smem + 2 * BUF + (it & 1) * 2560 + 4 * h2 * 40 + r;
      float ov[2][16];
      if (dir == 0) {
#pragma unroll
        for (int rt = 0; rt < 2; ++rt)
#pragma unroll
          for (int i = 0; i < 16; ++i) ov[rt][i] = bf2f(sO[(32 * rt + (i & 3) + 8 * (i >> 2) + 4 * h2) * RS + v0 + r]);
      }
#pragma unroll
      for (int rt = 0; rt < 2; ++rt)
#pragma unroll
        for (int i = 0; i < 16; ++i) {
          float val = X[rt][i];
          if (dir == 0) val += ov[rt][i];
          op[(32 * rt + (i & 3) + 8 * (i >> 2)) * 40] = (u16)f2bf(val);
        }
    }
    SB_();
    bf16x8 fa[2][4];
#define LDT_(kt, b) do { _Pragma("unroll") for (int rt = 0; rt < 2; ++rt) _Pragma("unroll") for (int s2 = 0; s2 < 2; ++s2) { \
      const u16* a0 = sK + (32 * rt + 16 * s2 + 8 * h2 + tq) * RS + 32 * (kt) + 16 * blk + 4 * tp; fa[b][rt * 2 + s2] = cat4(tr_rd(a0), tr_rd(a0 + 4 * RS)); } } while (0)
    LDT_(0, 0);
#pragma unroll
    for (int kt = 0; kt < 4; ++kt) {
      SB_();
      if (kt < 3) LDT_(kt + 1, (kt + 1) & 1);
#pragma unroll
      for (int g = 0; g < 4; ++g) {
        const float4 d4 = *(const float4*)(sD + 32 * kt + 8 * g + 4 * h2);
        S[kt][4 * g + 0] *= d4.x; S[kt][4 * g + 1] *= d4.y; S[kt][4 * g + 2] *= d4.z; S[kt][4 * g + 3] *= d4.w;
      }
      SB_();
      S[kt] = MFMA32(fa[kt & 1][0], vb[0][0], S[kt]); S[kt] = MFMA32(fa[kt & 1][1], vb[0][1], S[kt]);
      S[kt] = MFMA32(fa[kt & 1][2], vb[1][0], S[kt]); S[kt] = MFMA32(fa[kt & 1][3], vb[1][1], S[kt]);
    }
#undef LDT_
#undef SB_
    SEQ_BAR();
  }
}

__device__ void phase4b(const Params& p, int pass, unsigned char* smem, int dry) {
  const int bid = bid_opaque();
  if (bid >= 256) return;
  const int half = bid >> 7, b7 = bid & 127, x = b7 & 7, y = b7 >> 3;
  const int vh = y & 3, chain = x + 8 * (y >> 2);
  if (half == 0) gdn_seq(p, pass, chain, vh, smem, dry);
  else hgrn_seq(p, pass, chain, vh, smem, dry);
}

__device__ void phase5(const Params& p) {
  const int tid = tid_opaque(), lane = tid & 63, gw = bid_opaque() * 8 + (tid >> 6), nw = gridDim.x * 8;
  const u16* O = (const u16*)WS_H(p);
  u16* Yn = WS_QKVB(p);
  for (int r = gw; r < MPL; r += nw) {
    const int bl = r >> 13, s = r & 8191;
    const size_t rowfull = (size_t)(bl * TOK + CTXL + s);
    u32x4 of[4], ob[4], zz[4];
#pragma unroll
    for (int it = 0; it < 4; ++it) {
      const int g = it >> 1, cg = (it & 1) * 512 + lane * 8;
      of[it] = *(const u32x4*)(O + ((size_t)(g * 2 + 0) * MPL + r) * 1024 + cg);
      ob[it] = *(const u32x4*)(O + ((size_t)(g * 2 + 1) * MPL + r) * 1024 + cg);
      zz[it] = *(const u32x4*)(WS_YZ(p) + rowfull * 2048 + g * 1024 + cg);
    }
#pragma unroll
    for (int it = 0; it < 4; ++it) {
      const int g = it >> 1, cg = (it & 1) * 512 + lane * 8;
      float o[8]; float ss = 0.f;
#pragma unroll
      for (int e = 0; e < 4; ++e) {
        const u32 a = of[it][e], b = ob[it][e];
        o[2 * e] = bf2f(a & 0xFFFFu) + bf2f(b & 0xFFFFu); o[2 * e + 1] = bf2f(a >> 16) + bf2f(b >> 16);
        ss += o[2 * e] * o[2 * e] + o[2 * e + 1] * o[2 * e + 1];
      }
      ss += __shfl_xor(ss, 1, 64); ss += __shfl_xor(ss, 2, 64); ss += __shfl_xor(ss, 4, 64); ss += __shfl_xor(ss, 8, 64);
      const float rs = rsqrtf(ss * (1.f / 128.f) + 1e-6f);
      const float* wp = (g ? p.hb_w : p.ha_w) + cg;
      const float4 w0 = *(const float4*)wp, w1 = *(const float4*)(wp + 4);
      const float wv[8] = {w0.x, w0.y, w0.z, w0.w, w1.x, w1.y, w1.z, w1.w};
      u32x4 out;
#pragma unroll
      for (int e = 0; e < 4; ++e) {
        const u32 z = zz[it][e];
        out[e] = pk2bf(bf2f(z & 0xFFFFu) * o[2 * e] * rs * wv[2 * e], bf2f(z >> 16) * o[2 * e + 1] * rs * wv[2 * e + 1]);
      }
      *(u32x4*)(Yn + (size_t)r * 2048 + g * 1024 + cg) = out;
    }
  }
}

struct Epi2 {
  static constexpr bool PERM = false, AFTER_DRAIN = false;
  const float* x; const float* mod; float* xn; int pass;
  __device__ __forceinline__ void operator()(const f32x4 (&acc)[2][2][4][2], const pg8::Unit& u, int wr, int wc, int fr, int fq) const {
    const int row0 = u.pm * 256 + wr * 64 + fr, col0 = u.pn * 256 + wc * 32 + 4 * fq;
    const int b = pass * 2 + (row0 >> 13);
    const float* gp = mod + b * 3072 + 2048 + col0;
    f32x4 gt[2][2];
#pragma unroll
    for (int bj = 0; bj < 2; ++bj)
#pragma unroll
      for (int n = 0; n < 2; ++n) gt[bj][n] = *(const f32x4*)(gp + bj * 128 + n * 16);
#pragma unroll
    for (int ai = 0; ai < 2; ++ai)
#pragma unroll
      for (int m = 0; m < 4; ++m) {
        const int r = row0 + ai * 128 + m * 16;
        const size_t grow = (size_t)b * SEQ + (r & 8191);
#pragma unroll
        for (int bj = 0; bj < 2; ++bj)
#pragma unroll
          for (int n = 0; n < 2; ++n) {
            const size_t off = grow * 1024 + col0 + bj * 128 + n * 16;
            const f32x4 xv = *(const f32x4*)(x + off);
            *(f32x4*)(xn + off) = xv + gt[bj][n] * acc[ai][bj][m][n];
          }
      }
  }
};

__device__ void phase6(const Params& p, int pass, unsigned char* smem) {
  pg8::Gemm g; g.A = WS_QKVB(p); g.Bt = WS_wtout(p); g.M = MPL; g.N = 1024; g.K = 2048;
  pg8::StaticOrder S; S.init(g.M, g.N, (int)gridDim.x, bid_opaque());
  Epi2 E; E.x = p.x; E.mod = WS_mod(p); E.xn = p.out; E.pass = pass;
  pg8::gemm_phase<Epi2, pg8::StaticOrder, false>((PG8_LAS unsigned char*)smem, g, S, E, nullptr);
}

__device__ void phase7(const Params& p) {
  const int tid = tid_opaque(), lane = tid & 63, gw = bid_opaque() * 8 + (tid >> 6), nw = gridDim.x * 8;
  for (int r = gw; r < NB * SEQ; r += 2 * nw) {
    const int r1 = r + nw;
    const bool has1 = r1 < NB * SEQ;
    float* rp0 = p.out + (size_t)r * D;
    float* rp1 = p.out + (size_t)(has1 ? r1 : r) * D;
    float4 v0[4], v1[4]; float s0 = 0.f, s1 = 0.f;
#pragma unroll
    for (int i = 0; i < 4; ++i) { v0[i] = *(const float4*)(rp0 + i * 256 + lane * 4); v1[i] = *(const float4*)(rp1 + i * 256 + lane * 4); }
#pragma unroll
    for (int i = 0; i < 4; ++i) {
      s0 += v0[i].x * v0[i].x + v0[i].y * v0[i].y + v0[i].z * v0[i].z + v0[i].w * v0[i].w;
      s1 += v1[i].x * v1[i].x + v1[i].y * v1[i].y + v1[i].z * v1[i].z + v1[i].w * v1[i].w;
    }
    s0 = wave_sum(s0); s1 = wave_sum(s1);
    const float rs0 = rsqrtf(s0 * (1.f / 1024.f) + 1e-6f), rs1 = rsqrtf(s1 * (1.f / 1024.f) + 1e-6f);
#pragma unroll
    for (int i = 0; i < 4; ++i) {
      const float4 w = *(const float4*)(p.fnw + i * 256 + lane * 4);
      float4 o; o.x = v0[i].x * rs0 * w.x; o.y = v0[i].y * rs0 * w.y; o.z = v0[i].z * rs0 * w.z; o.w = v0[i].w * rs0 * w.w;
      *(float4*)(rp0 + i * 256 + lane * 4) = o;
      if (has1) { float4 o1; o1.x = v1[i].x * rs1 * w.x; o1.y = v1[i].y * rs1 * w.y; o1.z = v1[i].z * rs1 * w.z; o1.w = v1[i].w * rs1 * w.w; *(float4*)(rp1 + i * 256 + lane * 4) = o1; }
    }
  }
}

__global__ void __launch_bounds__(512, 2) mega(Params p) {
  extern __shared__ __attribute__((aligned(16))) unsigned char smem[];
  cg::grid_group grid = cg::this_grid();
  volatile LAS unsigned* xst = (volatile LAS unsigned*)(smem + 160 * 1024 - 256);
  if (threadIdx.x == 0) { xst[0] = 0u; xst[1] = 0u; xst[2] = 0u; xst[3] = 0u; }
  __syncthreads();
  const XcdBarrier xb = xcd_barrier_post(WS_bar(p), xst);
  phase0(p, smem, 0);
  grid.sync();
  for (int pass = 0; pass < 2; ++pass) {
    Params q = p;
    {
      int z = 0; asm volatile("" : "+s"(z));
      q.ws += z; q.x += z; q.ctx += z; q.out += z; q.conv_w += z; q.norm_w += z;
    }
    phase1(q, pass);
    if (pass == 0) phase0(q, smem, 1);
    xcd_barrier(xb);
    phase2(q, smem);
    xcd_barrier(xb);
    phase3(q, smem);
    hgrn_prep(q, pass, smem, 0);
    xcd_barrier(xb);
    gdn_prep(q, pass, smem);
    xcd_barrier(xb);
    phase4b(q, pass, smem, 0);
    xcd_barrier(xb);
    phase5(q);
    xcd_barrier(xb);
    phase6(q, pass, smem);
  }
  xcd_barrier(xb);
  phase7(p);
}

extern "C" void kernel_launch(void* const* d_in, const int* in_sizes, int n_in, void* d_out,
                              int out_size, void* d_ws, size_t ws_size, hipStream_t stream) {
  constexpr size_t kDynLds = 160 * 1024;
  static int grid_blocks = 0;
  if (!grid_blocks) {
    hipFuncSetAttribute((const void*)mega, hipFuncAttributeMaxDynamicSharedMemorySize, (int)kDynLds);
    int dev = 0, cus = 0, per_cu = 0;
    hipGetDevice(&dev);
    hipDeviceGetAttribute(&cus, hipDeviceAttributeMultiprocessorCount, dev);
    hipOccupancyMaxActiveBlocksPerMultiprocessor(&per_cu, mega, 512, kDynLds);
    if (per_cu > 1) per_cu = 1;
    grid_blocks = cus * per_cu;
  }
  Params p{};
  p.x = (const float*)d_in[0]; p.c = (const float*)d_in[1]; p.ctx = (const float*)d_in[2]; p.c_ctx = (const float*)d_in[3];
  p.norm_w = (const float*)d_in[4]; p.ada_w = (const float*)d_in[5]; p.ada_b = (const float*)d_in[6]; p.w_in = (const float*)d_in[7];
  p.conv_w = (const float*)d_in[8]; p.lb_logits = (const float*)d_in[9]; p.a_log = (const float*)d_in[10]; p.dt_bias = (const float*)d_in[11];
  p.ha_w = (const float*)d_in[12]; p.hb_w = (const float*)d_in[13]; p.w_out = (const float*)d_in[14]; p.fnw = (const float*)d_in[15];
  p.out = (float*)d_out;
  p.ws = (unsigned char*)d_ws;
  hipMemsetAsync(WS_bar(p), 0, (size_t)XCD_BAR_WORDS * 4, stream);
  void* args[] = {&p};
  hipError_t e = hipLaunchCooperativeKernel((void*)mega, dim3(grid_blocks), dim3(512), args, kDynLds, stream);
  if (e != hipSuccess) fprintf(stderr, "cooperative launch failed: %s (grid %d)\n", hipGetErrorString(e), grid_blocks);
}
```
